# Optimizing an MI355X kernel written in HIP

```python
import math
import jax
import jax.numpy as jnp
from jax import lax
import numpy as np

D_MODEL = 1024
BATCH = 16
SEQ = 4096
DEPTH = 4

GRID_W = 64
CTX_LEN = 256
EPS = 1e-6
D_FF = 2816
FFN_RES_W = 0.5
N_MOD = 9
HY_W = 256
SSD_HEADS = 8
SSD_HEAD_DIM = 64
SSD_W = SSD_HEADS * SSD_HEAD_DIM
SSD_GROUPS = 2
SSD_STATE = 128
SSD_CHUNK = 64
SC_W = 256
D_MIX = HY_W + SSD_W + SC_W
SHORT_K = 3
HY_ORDER = 2
HY_EMB = 33
HY_FH = 64
HY_FOUT = HY_ORDER * 2 * HY_W
HY_FAST = 0.3
HY_SLOW = 1.5
HY_TARGET = 1e-2
HY_IN = 3 * HY_W
SSD_XBC = SSD_W + 2 * SSD_GROUPS * SSD_STATE
SC_IN = 3 * SC_W
IN_SPLITS = (HY_IN, HY_IN + SSD_W, HY_IN + SSD_W + SSD_XBC, HY_IN + SSD_W + SSD_XBC + 2 * SSD_HEADS)
D_IN = IN_SPLITS[-1] + SC_IN

kernel_name = 'hybrid_hyena_ssd_shortconv_dit'


def rmsnorm(x, g):
    xf = x.astype(jnp.float32)
    y = xf * lax.rsqrt(jnp.mean(xf * xf, axis=-1, keepdims=True) + EPS)
    return (y * g.astype(jnp.float32)).astype(x.dtype)


def sub_in(x, g_pre, mod, i):
    return rmsnorm(x, g_pre) * (1.0 + mod[:, :, 3 * i + 1]) + mod[:, :, 3 * i]


def sub_out(x, y, g_post, mod, i, res_w):
    return x + res_w * mod[:, :, 3 * i + 2] * rmsnorm(y, g_post)


def swiglu(h, w_in, w_out):
    g, u = jnp.split(h @ w_in, 2, axis=-1)
    return (jax.nn.silu(g) * u) @ w_out


def dwconv(u, w, b, n_seg):
    bsz, L, C = u.shape
    K = w.shape[0]
    p = K // 2
    seg = L // n_seg
    up = jnp.pad(u.reshape(bsz, n_seg, seg, C), ((0, 0), (0, 0), (p, p), (0, 0)))
    y = up[:, :, 0:seg] * w[0]
    for j in range(1, K):
        y = y + up[:, :, j:j + seg] * w[j]
    if b is not None:
        y = y + b
    return y.reshape(bsz, L, C)


def hyena_filters(L, fw1, fb1, fw2, fb2, fw3, fb3, fw4, freq):
    f32 = jnp.float32
    t = jnp.linspace(0.0, 1.0, L, dtype=f32)[:, None]
    bands = (HY_EMB - 1) // 2
    w = 2.0 * math.pi * jnp.arange(L, dtype=f32)[:, None] / L
    f = jnp.linspace(1e-4, bands - 1, bands, dtype=f32)[None, :]
    z = jnp.concatenate([t, jnp.cos(f * w), -jnp.sin(f * w)], axis=-1)
    fr = freq.astype(f32)
    h = jnp.sin(fr * (z @ fw1.astype(f32) + fb1.astype(f32)))
    h = jnp.sin(fr * (h @ fw2.astype(f32) + fb2.astype(f32)))
    h = jnp.sin(fr * (h @ fw3.astype(f32) + fb3.astype(f32)))
    h = h @ fw4.astype(f32)
    deltas = jnp.linspace(math.log(HY_TARGET) / HY_SLOW, math.log(HY_TARGET) / HY_FAST, HY_W, dtype=f32)
    decay = jnp.exp(-t * jnp.abs(deltas))
    h = h.reshape(L, HY_ORDER, 2, HY_W) * decay[:, None, None, :]
    k = jnp.concatenate([h[:, :, 0], jnp.zeros((1, HY_ORDER, HY_W), f32), h[:0:-1, :, 1]], axis=0)
    return jnp.fft.rfft(k, axis=0)


def hyena_long_conv(u, kf, bias):
    L = u.shape[1]
    v, x1, x2 = jnp.split(u.astype(jnp.float32), 3, axis=-1)
    bias = bias.astype(jnp.float32)
    z = v
    for o, gate in enumerate((x1, x2)):
        zf = jnp.fft.rfft(z, n=2 * L, axis=1)
        z = gate * (jnp.fft.irfft(zf * kf[:, o], n=2 * L, axis=1)[:, :L] + bias[o] * z)
    return z


def ssd_scan(xdt, dA, Bm, Cm, h0, want_y):
    b, l, nh, p = xdt.shape
    g = Bm.shape[2]
    r = nh // g
    n = Bm.shape[-1]
    q = SSD_CHUNK
    c = l // q
    X = xdt.reshape(b, c, q, g, r, p)
    A = dA.reshape(b, c, q, g, r)
    Bc = Bm.reshape(b, c, q, g, n)
    Cc = Cm.reshape(b, c, q, g, n)
    Acs = jnp.cumsum(A, axis=2)
    A_tot = Acs[:, :, -1]
    decay_to_end = jnp.exp(A_tot[:, :, None] - Acs)
    chunk_states = jnp.einsum('bcqgn,bcqgr,bcqgrp->bcgrpn', Bc, decay_to_end, X)

    def step(h_prev, inp):
        s, a = inp
        return jnp.exp(a)[..., None, None] * h_prev + s, h_prev

    h_final, h_starts = lax.scan(step, h0, (jnp.moveaxis(chunk_states, 1, 0), jnp.moveaxis(A_tot, 1, 0)))
    if not want_y:
        return h_final
    h_starts = jnp.moveaxis(h_starts, 0, 1)
    seg = Acs[:, :, :, None] - Acs[:, :, None, :]
    mask = jnp.tril(jnp.ones((q, q), dtype=bool))[:, :, None, None]
    Lmat = jnp.exp(jnp.where(mask, seg, -jnp.inf))
    scores = jnp.einsum('bclgn,bcsgn->bclsg', Cc, Bc)
    y_diag = jnp.einsum('bclsg,bclsgr,bcsgrp->bclgrp', scores, Lmat, X)
    y_off = jnp.einsum('bclgn,bcgrpn,bclgr->bclgrp', Cc, h_starts, jnp.exp(Acs))
    return (y_diag + y_off).reshape(b, l, nh, p), h_final


def token_mixers(p, n_seg, kf, h0_f, h0_b, want_out, hy_conv_w, hy_conv_b, hy_bias, ssd_conv_w, ssd_conv_b,
                 ssd_a_log, ssd_dt_bias, ssd_d, sc_conv_w, mix_gain):
    f32 = jnp.float32
    bsz, L, _ = p.shape
    hy, z, xbc, dt_raw, scp = jnp.split(p, IN_SPLITS, axis=-1)
    xbc = jax.nn.silu(dwconv(xbc, ssd_conv_w, ssd_conv_b, n_seg)).astype(f32)
    xs, Bm, Cm = jnp.split(xbc, [SSD_W, SSD_W + SSD_GROUPS * SSD_STATE], axis=-1)
    xs = xs.reshape(bsz, L, SSD_HEADS, SSD_HEAD_DIM)
    Bm = Bm.reshape(bsz, L, SSD_GROUPS, SSD_STATE)
    Cm = Cm.reshape(bsz, L, SSD_GROUPS, SSD_STATE)
    dt = jax.nn.softplus(dt_raw.astype(f32).reshape(bsz, L, 2, SSD_HEADS) + ssd_dt_bias.astype(f32))
    a = -jnp.exp(ssd_a_log.astype(f32))
    dt_f = dt[:, :, 0]
    res_f = ssd_scan(xs * dt_f[..., None], dt_f * a[0], Bm, Cm, h0_f, want_out)
    rev = lambda t: jnp.flip(t, axis=1)
    dt_b = rev(dt[:, :, 1])
    res_b = ssd_scan(rev(xs) * dt_b[..., None], dt_b * a[1], rev(Bm), rev(Cm), h0_b, want_out)
    if not want_out:
        return None, res_f, res_b
    (y_f, h_f), (y_b, h_b) = res_f, res_b
    y = y_f + rev(y_b) + ssd_d.astype(f32)[:, None] * xs
    y_ssd = rmsnorm(y.reshape(bsz, L, SSD_W) * jax.nn.silu(z.astype(f32)), mix_gain[HY_W:HY_W + SSD_W])
    y_hy = rmsnorm(hyena_long_conv(dwconv(hy, hy_conv_w, hy_conv_b, n_seg), kf, hy_bias), mix_gain[:HY_W])
    gb, gc, hx = jnp.split(scp, 3, axis=-1)
    y_sc = rmsnorm(gb * dwconv(gc * hx, sc_conv_w, None, n_seg), mix_gain[HY_W + SSD_W:])
    out = jnp.concatenate([y_hy.astype(p.dtype), y_ssd.astype(p.dtype), y_sc], axis=-1)
    return out, h_f, h_b


def setup_inputs(seed: int = 0) -> dict:
    key = jax.random.key(seed)
    ks = iter(jax.random.split(key, 40))
    f32 = jnp.float32
    nrm = lambda shape, scale: scale * jax.random.normal(next(ks), shape, f32)
    gain = lambda shape: 1.0 + 0.02 * jax.random.normal(next(ks), shape, f32)
    x = nrm((BATCH, SEQ, D_MODEL), 1.0)
    c = nrm((BATCH, D_MODEL), 1.0)
    ctx = nrm((BATCH, CTX_LEN, D_MODEL), 1.0)
    c_ctx = nrm((D_MODEL,), 1.0)
    w_mod = nrm((DEPTH, D_MODEL, N_MOD * D_MODEL), 0.5 * D_MODEL ** -0.5)
    b_mod = nrm((DEPTH, N_MOD * D_MODEL), 0.02)
    norm_g = gain((DEPTH, 6, D_MODEL))
    ffn_w_in = nrm((DEPTH, 2, D_MODEL, 2 * D_FF), D_MODEL ** -0.5)
    ffn_w_out = nrm((DEPTH, 2, D_FF, D_MODEL), D_FF ** -0.5)
    w_in = nrm((DEPTH, D_MODEL, D_IN), D_MODEL ** -0.5)
    w_out = nrm((DEPTH, D_MIX, D_MODEL), D_MIX ** -0.5)
    hy_conv_w = nrm((DEPTH, SHORT_K, HY_IN), SHORT_K ** -0.5)
    hy_conv_b = nrm((DEPTH, HY_IN), 0.02)
    hy_fw1 = nrm((DEPTH, HY_EMB, HY_FH), HY_EMB ** -0.5)
    hy_fb1 = nrm((DEPTH, HY_FH), 0.02)
    hy_fw2 = nrm((DEPTH, HY_FH, HY_FH), HY_FH ** -0.5)
    hy_fb2 = nrm((DEPTH, HY_FH), 0.02)
    hy_fw3 = nrm((DEPTH, HY_FH, HY_FH), HY_FH ** -0.5)
    hy_fb3 = nrm((DEPTH, HY_FH), 0.02)
    hy_fw4 = nrm((DEPTH, HY_FH, HY_FOUT), HY_FH ** -0.5)
    hy_freq = gain((DEPTH, HY_FH))
    hy_bias = nrm((DEPTH, HY_ORDER, HY_W), 1.0)
    ssd_conv_w = nrm((DEPTH, SHORT_K, SSD_XBC), SHORT_K ** -0.5)
    ssd_conv_b = nrm((DEPTH, SSD_XBC), 0.02)
    ssd_a_log = jnp.log(jax.random.uniform(next(ks), (DEPTH, 2, SSD_HEADS), f32, minval=1.0, maxval=16.0))
    u = jax.random.uniform(next(ks), (DEPTH, 2, SSD_HEADS), f32)
    dt0 = jnp.exp(u * (math.log(0.1) - math.log(1e-3)) + math.log(1e-3))
    ssd_dt_bias = dt0 + jnp.log(-jnp.expm1(-dt0))
    ssd_d = gain((DEPTH, SSD_HEADS))
    sc_conv_w = nrm((DEPTH, SHORT_K, SC_W), SHORT_K ** -0.5)
    mix_gain = gain((DEPTH, D_MIX))
    return {'x': x, 'c': c, 'ctx': ctx, 'c_ctx': c_ctx, 'w_mod': w_mod, 'b_mod': b_mod, 'norm_g': norm_g,
            'ffn_w_in': ffn_w_in, 'ffn_w_out': ffn_w_out, 'w_in': w_in, 'w_out': w_out,
            'hy_conv_w': hy_conv_w, 'hy_conv_b': hy_conv_b, 'hy_fw1': hy_fw1, 'hy_fb1': hy_fb1,
            'hy_fw2': hy_fw2, 'hy_fb2': hy_fb2, 'hy_fw3': hy_fw3, 'hy_fb3': hy_fb3, 'hy_fw4': hy_fw4,
            'hy_freq': hy_freq, 'hy_bias': hy_bias, 'ssd_conv_w': ssd_conv_w, 'ssd_conv_b': ssd_conv_b,
            'ssd_a_log': ssd_a_log, 'ssd_dt_bias': ssd_dt_bias, 'ssd_d': ssd_d, 'sc_conv_w': sc_conv_w,
            'mix_gain': mix_gain}


def reference(x, c, ctx, c_ctx, w_mod, b_mod, norm_g, ffn_w_in, ffn_w_out, w_in, w_out, hy_conv_w, hy_conv_b,
              hy_fw1, hy_fb1, hy_fw2, hy_fb2, hy_fw3, hy_fb3, hy_fw4, hy_freq, hy_bias, ssd_conv_w, ssd_conv_b,
              ssd_a_log, ssd_dt_bias, ssd_d, sc_conv_w, mix_gain):
    bsz, n_lat, _ = x.shape
    rows = n_lat // GRID_W
    cbsz, ctx_len, _ = ctx.shape
    silu_c = jax.nn.silu(c)
    silu_cc = jax.nn.silu(c_ctx)
    xc = ctx
    h_zero = jnp.zeros((cbsz, SSD_GROUPS, SSD_HEADS // SSD_GROUPS, SSD_HEAD_DIM, SSD_STATE), jnp.float32)
    for l in range(DEPTH):
        last = l == DEPTH - 1
        mod_x = (silu_c @ w_mod[l] + b_mod[l]).reshape(bsz, 1, N_MOD, D_MODEL)
        mod_c = (silu_cc @ w_mod[l] + b_mod[l]).reshape(1, 1, N_MOD, D_MODEL)
        g = norm_g[l]
        mp = (hy_conv_w[l], hy_conv_b[l], hy_bias[l], ssd_conv_w[l], ssd_conv_b[l], ssd_a_log[l],
              ssd_dt_bias[l], ssd_d[l], sc_conv_w[l], mix_gain[l])
        fp = (hy_fw1[l], hy_fb1[l], hy_fw2[l], hy_fb2[l], hy_fw3[l], hy_fb3[l], hy_fw4[l], hy_freq[l])
        x = sub_out(x, swiglu(sub_in(x, g[0], mod_x, 0), ffn_w_in[l, 0], ffn_w_out[l, 0]), g[1], mod_x, 0, FFN_RES_W)
        xc = sub_out(xc, swiglu(sub_in(xc, g[0], mod_c, 0), ffn_w_in[l, 0], ffn_w_out[l, 0]), g[1], mod_c, 0, FFN_RES_W)
        pc = sub_in(xc, g[2], mod_c, 1) @ w_in[l]
        kf_ctx = None if last else hyena_filters(ctx_len, *fp)
        y_c, h_f, h_b = token_mixers(pc, 1, kf_ctx, h_zero, h_zero, not last, *mp)
        pl = sub_in(x, g[2], mod_x, 1) @ w_in[l]
        y_l, _, _ = token_mixers(pl, rows, hyena_filters(n_lat, *fp), h_f, h_b, True, *mp)
        x = sub_out(x, y_l @ w_out[l], g[3], mod_x, 1, 1.0)
        x = sub_out(x, swiglu(sub_in(x, g[4], mod_x, 2), ffn_w_in[l, 1], ffn_w_out[l, 1]), g[5], mod_x, 2, FFN_RES_W)
        if not last:
            xc = sub_out(xc, y_c @ w_out[l], g[3], mod_c, 1, 1.0)
            xc = sub_out(xc, swiglu(sub_in(xc, g[4], mod_c, 2), ffn_w_in[l, 1], ffn_w_out[l, 1]), g[5], mod_c, 2, FFN_RES_W)
    return x
```

```cpp
#include <hip/hip_runtime.h>
#include <hip/hip_cooperative_groups.h>
#include <cstdio>
#include <cstring>
namespace cg = cooperative_groups;

typedef unsigned short bf16_t;
typedef short bf16x8 __attribute__((ext_vector_type(8)));
typedef float f32x4 __attribute__((ext_vector_type(4)));
typedef unsigned u32x4 __attribute__((ext_vector_type(4)));
typedef unsigned u32x2 __attribute__((ext_vector_type(2)));
__device__ __forceinline__ u32x4 mk4(unsigned a, unsigned b, unsigned c, unsigned d) { return (u32x4){a, b, c, d}; }
__device__ __forceinline__ u32x4 zero_u4() { unsigned z = 0u; asm volatile("" : "+v"(z)); return (u32x4){z, z, z, z}; }
__device__ __forceinline__ u32x2 mk2(unsigned a, unsigned b) { return (u32x2){a, b}; }

constexpr int NB = 16, SEQ = 4096, DM = 1024, DEPTH = 4, LC = 256;
constexpr int TL = NB * SEQ, TC = NB * LC, TA = TL + TC;
constexpr int DFF = 2816, DIN = 3088;
constexpr int MODROW = 9 * DM;
constexpr int MODLAYER = 17 * MODROW;
constexpr int HALF_LDS = 71680;
constexpr int LDS_BYTES = 2 * HALF_LDS;
constexpr int LDS_TOTAL = LDS_BYTES + 16;
constexpr float EPS = 1e-6f;

struct Params {
  const float *x, *c, *ctx, *c_ctx, *w_mod, *b_mod, *norm_g, *ffn_w_in, *ffn_w_out, *w_in, *w_out;
  const float *hy_conv_w, *hy_conv_b, *fw1, *fb1, *fw2, *fb2, *fw3, *fb3, *fw4, *freq, *hy_bias;
  const float *ssd_conv_w, *ssd_conv_b, *a_log, *dt_bias, *ssd_d, *sc_conv_w, *mix_gain;
  float* out;
  bf16_t *wFin0, *wFin1, *wFout0, *wFout1, *wIn, *wOut;
  bf16_t *bufA, *bufB, *big, *hyT;
  float *mod, *kfl, *kfc, *dtb;
  bf16_t* xs;
  unsigned* bar;
  int ph_lo, ph_hi;
};

#define GLAS __attribute__((address_space(3)))
__device__ __forceinline__ int lane_id() {
  int l; asm volatile("v_mbcnt_lo_u32_b32 %0, -1, 0\n\tv_mbcnt_hi_u32_b32 %0, -1, %0" : "=v"(l)); return l;
}
__device__ __forceinline__ int otid(int wvi) { int t = (wvi & 3) * 64 + lane_id(); asm volatile("" : "+v"(t)); return t; }
__device__ __forceinline__ int obid(int wvi) { int b = __builtin_amdgcn_readfirstlane((int)(blockIdx.x * 2 + (wvi >> 2))); asm volatile("" : "+s"(b)); return b; }
__device__ __forceinline__ int vgrid() { return gridDim.x * 2; }
typedef __bf16 bf16v2_t __attribute__((ext_vector_type(2)));
typedef float f32x2 __attribute__((ext_vector_type(2)));
__device__ __forceinline__ unsigned pk2(float lo, float hi) {
  f32x2 v = {lo, hi};
  bf16v2_t b = __builtin_convertvector(v, bf16v2_t);
  return __builtin_bit_cast(unsigned, b);
}
__device__ __forceinline__ bf16_t f2bf(float f) { return (bf16_t)(pk2(f, 0.f) & 0xffffu); }
__device__ __forceinline__ float bf2f(bf16_t h) { return __uint_as_float(((unsigned)h) << 16); }
__device__ __forceinline__ float lo2f(unsigned u) { return __uint_as_float(u << 16); }
__device__ __forceinline__ float hi2f(unsigned u) { return __uint_as_float(u & 0xffff0000u); }
__device__ __forceinline__ void unpack8(const u32x4& u, float* f) {
  f[0] = lo2f(u.x); f[1] = hi2f(u.x); f[2] = lo2f(u.y); f[3] = hi2f(u.y);
  f[4] = lo2f(u.z); f[5] = hi2f(u.z); f[6] = lo2f(u.w); f[7] = hi2f(u.w);
}
__device__ __forceinline__ u32x4 pack8(const float* f) {
  return mk4(pk2(f[0], f[1]), pk2(f[2], f[3]), pk2(f[4], f[5]), pk2(f[6], f[7]));
}
__device__ __forceinline__ float silu_f(float x) { return x * __builtin_amdgcn_rcpf(1.f + __expf(-x)); }
__device__ __forceinline__ float softplus_f(float x) {
  if (x > 20.f) return x;
  const float e = __expf(x);
  return (e < 0.03f) ? e * (1.f - e * (0.5f - e * (1.f / 3.f - 0.25f * e))) : __logf(1.f + e);
}
__device__ __forceinline__ float wave_sum(float v) {
  const int l4 = lane_id() << 2;
#pragma unroll
  for (int o = 32; o >= 1; o >>= 1) v += __int_as_float(__builtin_amdgcn_ds_bpermute(l4 ^ (o << 2), __float_as_int(v)));
  return v;
}
__device__ __forceinline__ f32x4 zero4() { float z = 0.f; asm volatile("" : "+v"(z)); return (f32x4){z, z, z, z}; }
__device__ __forceinline__ f32x4 mfma16(bf16x8 a, bf16x8 b, f32x4 c) {
  return __builtin_amdgcn_mfma_f32_16x16x32_bf16(a, b, c, 0, 0, 0);
}
__device__ __forceinline__ bf16x8 ldfrag(const bf16_t* p) { return *reinterpret_cast<const bf16x8*>(p); }
__device__ __forceinline__ bf16x8 gather8(const bf16_t* p, int stride) {
  bf16x8 r;
#pragma unroll
  for (int j = 0; j < 8; ++j) r[j] = (short)p[j * stride];
  return r;
}

struct NormCfg {
  const float* src_lat; const float* src_ctx;
  bf16_t* xs;
  float* out32;
  const bf16_t* y; const float* g_post; const float* mod_post; int gate_i; float res_w;
  const float* g_pre; const float* mod_pre; int shift_i; bf16_t* h; int rows;
};

__device__ __forceinline__ void norm_phase(const NormCfg& cf, int wvi) {
  const int tid = otid(wvi); const int lane = tid & 63, w = tid >> 6;
  const int nw = vgrid() * 4, gw = obid(wvi) * 4 + w;
  const int per = (cf.rows + nw - 1) / nw;
  const int wv8 = (gw & 7);
  const int r0 = (gw >> 3) * per * 8 + wv8, r1 = min(cf.rows, (gw >> 3) * per * 8 + per * 8);
  if (r0 >= r1) return;
  const bool has_post = cf.y != nullptr, has_pre = cf.h != nullptr;
  const bool src32 = cf.src_lat != nullptr;
  auto ld8 = [&](const float* base, int i, float* d) {
    const float4 a = reinterpret_cast<const float4*>(base)[2 * (lane + 64 * i)];
    const float4 c = reinterpret_cast<const float4*>(base)[2 * (lane + 64 * i) + 1];
    d[0] = a.x; d[1] = a.y; d[2] = a.z; d[3] = a.w; d[4] = c.x; d[5] = c.y; d[6] = c.z; d[7] = c.w;
  };
  float gpo[2][8], gpr[2][8], gate[2][8], sh[2][8], sc[2][8];
#pragma unroll
  for (int i = 0; i < 2; ++i) {
#pragma unroll
    for (int k = 0; k < 8; ++k) { gpo[i][k] = 0.f; gpr[i][k] = 0.f; gate[i][k] = 0.f; sh[i][k] = 0.f; sc[i][k] = 0.f; }
    if (has_post) ld8(cf.g_post, i, gpo[i]);
    if (has_pre) ld8(cf.g_pre, i, gpr[i]);
  }
  int cur_m = -1;
  float4 xn[2][2]; u32x4 xb[2], yn[2];
  auto fetch = [&](int row) {
    if (src32) {
      const float* src = (row < TL) ? cf.src_lat + (size_t)row * DM : cf.src_ctx + (size_t)(row - TL) * DM;
#pragma unroll
      for (int i = 0; i < 2; ++i) {
        xn[i][0] = reinterpret_cast<const float4*>(src)[2 * (lane + 64 * i)];
        xn[i][1] = reinterpret_cast<const float4*>(src)[2 * (lane + 64 * i) + 1];
      }
    } else {
      const u32x4* xp = reinterpret_cast<const u32x4*>(cf.xs + (size_t)row * DM);
#pragma unroll
      for (int i = 0; i < 2; ++i) xb[i] = xp[lane + 64 * i];
    }
    if (has_post) {
      const u32x4* yp = reinterpret_cast<const u32x4*>(cf.y + (size_t)row * DM);
#pragma unroll
      for (int i = 0; i < 2; ++i) yn[i] = yp[lane + 64 * i];
    }
  };
  fetch(r0);
  for (int row = r0; row < r1; row += 8) {
    float xv[2][8], yv[2][8];
#pragma unroll
    for (int i = 0; i < 2; ++i) {
      if (src32) {
        xv[i][0] = xn[i][0].x; xv[i][1] = xn[i][0].y; xv[i][2] = xn[i][0].z; xv[i][3] = xn[i][0].w;
        xv[i][4] = xn[i][1].x; xv[i][5] = xn[i][1].y; xv[i][6] = xn[i][1].z; xv[i][7] = xn[i][1].w;
      } else unpack8(xb[i], xv[i]);
      unpack8(yn[i], yv[i]);
    }
    if (row + 8 < r1) fetch(row + 8);
    const int mrow = (row < TL) ? (row >> 12) : 16;
    if (mrow != cur_m) {
      cur_m = mrow;
#pragma unroll
      for (int i = 0; i < 2; ++i) {
        if (has_post) ld8(cf.mod_post + (size_t)mrow * MODROW + cf.gate_i * DM, i, gate[i]);
        if (has_pre) {
          ld8(cf.mod_pre + (size_t)mrow * MODROW + cf.shift_i * DM, i, sh[i]);
          ld8(cf.mod_pre + (size_t)mrow * MODROW + (cf.shift_i + 1) * DM, i, sc[i]);
        }
      }
    }
    if (has_post) {
      float ss = 0.f;
#pragma unroll
      for (int i = 0; i < 2; ++i)
#pragma unroll
        for (int k = 0; k < 8; ++k) ss += yv[i][k] * yv[i][k];
      ss = wave_sum(ss);
      const float rstd = rsqrtf(ss * (1.f / DM) + EPS) * cf.res_w;
#pragma unroll
      for (int i = 0; i < 2; ++i)
#pragma unroll
        for (int k = 0; k < 8; ++k) xv[i][k] += gate[i][k] * gpo[i][k] * yv[i][k] * rstd;
      if (cf.out32) {
        float4* op = reinterpret_cast<float4*>(cf.out32 + (size_t)row * DM);
#pragma unroll
        for (int i = 0; i < 2; ++i) {
          op[2 * (lane + 64 * i)] = make_float4(xv[i][0], xv[i][1], xv[i][2], xv[i][3]);
          op[2 * (lane + 64 * i) + 1] = make_float4(xv[i][4], xv[i][5], xv[i][6], xv[i][7]);
        }
      } else {
        u32x4* xp = reinterpret_cast<u32x4*>(cf.xs + (size_t)row * DM);
#pragma unroll
        for (int i = 0; i < 2; ++i) {
          const u32x4 pk = pack8(xv[i]);
          xp[lane + 64 * i] = pk;
          unpack8(pk, xv[i]);
        }
      }
    }
    if (has_pre) {
      float ss = 0.f;
#pragma unroll
      for (int i = 0; i < 2; ++i)
#pragma unroll
        for (int k = 0; k < 8; ++k) ss += xv[i][k] * xv[i][k];
      ss = wave_sum(ss);
      const float rstd = rsqrtf(ss * (1.f / DM) + EPS);
      u32x4* hp = reinterpret_cast<u32x4*>(cf.h + (size_t)row * DM);
#pragma unroll
      for (int i = 0; i < 2; ++i) {
        float hv[8];
#pragma unroll
        for (int k = 0; k < 8; ++k) hv[k] = xv[i][k] * rstd * gpr[i][k] * (1.f + sc[i][k]) + sh[i][k];
        hp[lane + 64 * i] = pack8(hv);
      }
    }
  }
}

enum { EPI_PLAIN = 0, EPI_SWIGLU = 1, EPI_INPROJ = 2 };
constexpr int GBM = 256, GBK = 64, GHALF = 128, GHT = GHALF * GBK, GNXCD = 8, GWGM = 8;

__device__ __forceinline__ int lds_byte(int r, int c) {
  const int st = (r >> 4) * 2 + (c >> 5), rr = r & 15, cc = c & 31, ob = rr * 64 + cc * 2;
  return st * 1024 + (ob ^ (((ob >> 9) & 1) << 5));
}
__device__ __forceinline__ void stage_rc(int b, int& R, int& C) {
  const int st = b / 1024, sb = b % 1024, swz = sb ^ (((sb >> 9) & 1) << 5);
  R = (st >> 1) * 16 + swz / 64; C = (st & 1) * 32 + (swz % 64) / 2;
}

__device__ __forceinline__ void gemm_phase(const Params& p, int l, const bf16_t* __restrict__ A, const bf16_t* __restrict__ Bt, int M, int N, int K,
                           int epi, bf16_t* __restrict__ outp, char* smem, int wvi) {
  GLAS unsigned char* lds = (GLAS unsigned char*)smem;
  const int wid = wvi; int tidx = wvi * 64 + lane_id(); asm volatile("" : "+v"(tidx));
  const int lane = tidx & 63, wr = wid >> 2, wc = wid & 3, fr = lane & 15, fq = lane >> 4;
  const int nt = K / GBK;
  unsigned voff[2];
#pragma unroll
  for (int i = 0; i < 2; ++i) { int R, C; stage_rc(tidx * 16 + i * 8192, R, C); voff[i] = (unsigned)(R * K + C) * 2u; }
  const size_t kstep = (size_t)(GBK * 2), hstep = (size_t)GHALF * K * 2, tstep = 2 * hstep;
  const unsigned ldsw = (unsigned)wid * 1024u;
  const int aoff = lds_byte(wr * 64 + fr, fq * 8), boff = lds_byte(wc * 32 + fr, fq * 8);
  constexpr int HTB = GHT * 2;
#define G_SA(b, h) (((b) * 2 + (h)) * HTB)
#define G_SB(b, h) ((4 + (b) * 2 + (h)) * HTB)
#define G_STAGE(bufoff, gbase) do { _Pragma("unroll") for (int _i = 0; _i < 2; ++_i) \
    __builtin_amdgcn_global_load_lds((const unsigned*)((const char*)(gbase) + voff[_i]), (GLAS unsigned*)(lds + (bufoff) + ldsw + _i * 8192), 16, 0, 0); } while (0)
#define G_LDA(dst, b, h) do { _Pragma("unroll") for (int m = 0; m < 4; ++m) _Pragma("unroll") for (int k = 0; k < 2; ++k) \
    dst[m][k] = *(const GLAS bf16x8*)(lds + G_SA(b, h) + aoff + m * 2048 + k * 1024); } while (0)
#define G_LDB(dst, b, h) do { _Pragma("unroll") for (int n = 0; n < 2; ++n) _Pragma("unroll") for (int k = 0; k < 2; ++k) \
    dst[n][k] = *(const GLAS bf16x8*)(lds + G_SB(b, h) + boff + n * 2048 + k * 1024); } while (0)
#define G_MMA(ai, bj, At_, Bt_) do { __builtin_amdgcn_s_setprio(1); \
    _Pragma("unroll") for (int m = 0; m < 4; ++m) _Pragma("unroll") for (int n = 0; n < 2; ++n) _Pragma("unroll") for (int k = 0; k < 2; ++k) \
      acc[ai][bj][m][n] = __builtin_amdgcn_mfma_f32_16x16x32_bf16(Bt_[n][k], At_[m][k], acc[ai][bj][m][n], 0, 0, 0); \
    __builtin_amdgcn_s_setprio(0); } while (0)
#define G_WAIT_V(n) asm volatile("s_waitcnt vmcnt(" #n ")" ::: "memory")
#define G_WAIT_L(n) asm volatile("s_waitcnt lgkmcnt(" #n ")" ::: "memory")
#define G_BAR __builtin_amdgcn_s_barrier()
#define G_SCHED __builtin_amdgcn_sched_barrier(0)
  const int nM = M / GBM, nN = N / GBM, nwg = nM * nN;
  auto tile_of = [&](int Lw, int& pm_, int& pn_) {
    int wgid = Lw;
    { const int q = nwg / GNXCD, r = nwg % GNXCD, xcd = wgid % GNXCD, off = wgid / GNXCD; wgid = (xcd < r ? xcd * (q + 1) : r * (q + 1) + (xcd - r) * q) + off; }
    const int nig = GWGM * nN, gid = wgid / nig, fm = gid * GWGM, gsz = min(nM - fm, GWGM);
    pm_ = fm + ((wgid % nig) % gsz); pn_ = (wgid % nig) / gsz;
  };
  int Lw = blockIdx.x;
  if (Lw < nwg) {
    int pm, pn; tile_of(Lw, pm, pn);
    const char* cA = (const char*)A + (size_t)pm * tstep;
    const char* cB = (const char*)Bt + (size_t)pn * tstep;
    f32x4 acc[2][2][4][2];
#pragma unroll
    for (int a = 0; a < 2; ++a)
#pragma unroll
      for (int b = 0; b < 2; ++b)
#pragma unroll
        for (int m = 0; m < 4; ++m)
#pragma unroll
          for (int n = 0; n < 2; ++n) acc[a][b][m][n] = zero4();
    bf16x8 At[4][2], B0[2][2], B1[2][2];
    G_STAGE(G_SB(0, 0), cB); G_STAGE(G_SA(0, 0), cA); G_STAGE(G_SB(0, 1), cB + hstep); G_STAGE(G_SA(0, 1), cA + hstep);
    if (wr == 1) G_BAR;
    G_WAIT_V(4); G_BAR;
    G_STAGE(G_SB(1, 0), cB + kstep); G_STAGE(G_SA(1, 0), cA + kstep); G_STAGE(G_SB(1, 1), cB + hstep + kstep);
    G_WAIT_V(6); G_BAR;
    for (;;) {
      const int Ln = Lw + gridDim.x;
      const bool has_next = Ln < nwg;
      int npm = pm, npn = pn;
      if (has_next) tile_of(Ln, npm, npn);
      const char* nA = (const char*)A + (size_t)npm * tstep; const char* nB = (const char*)Bt + (size_t)npn * tstep;
      for (int t = 0; t < nt; t += 2) {
        const bool lastt = (t == nt - 2);
        const char* a1 = cA + (size_t)(t + 1) * kstep;
        const char* a2 = lastt ? nA : cA + (size_t)(t + 2) * kstep; const char* b2 = lastt ? nB : cB + (size_t)(t + 2) * kstep;
        const char* a3 = a2 + kstep; const char* b3 = b2 + kstep;
        G_LDB(B0, 0, 0); G_SCHED; G_LDA(At, 0, 0); G_STAGE(G_SA(1, 1), a1 + hstep);
        G_WAIT_L(8); G_BAR; G_WAIT_L(0); G_MMA(0, 0, At, B0); G_BAR; G_SCHED;
        G_LDB(B1, 0, 1); G_STAGE(G_SB(0, 0), b2);
        G_BAR; G_WAIT_L(0); G_MMA(0, 1, At, B1); G_BAR;
        G_LDA(At, 0, 1); G_STAGE(G_SA(0, 0), a2);
        G_BAR; G_WAIT_L(0); G_MMA(1, 0, At, B0); G_BAR; G_SCHED;
        G_STAGE(G_SB(0, 1), b2 + hstep);
        G_WAIT_V(6); G_BAR; G_MMA(1, 1, At, B1); G_BAR;
        G_LDB(B0, 1, 0); G_SCHED; G_LDA(At, 1, 0); G_STAGE(G_SA(0, 1), a2 + hstep);
        G_WAIT_L(8); G_BAR; G_WAIT_L(0); G_MMA(0, 0, At, B0); G_BAR; G_SCHED;
        G_LDB(B1, 1, 1); G_STAGE(G_SB(1, 0), b3);
        G_BAR; G_WAIT_L(0); G_MMA(0, 1, At, B1); G_BAR;
        G_LDA(At, 1, 1); G_STAGE(G_SA(1, 0), a3);
        G_BAR; G_WAIT_L(0); G_MMA(1, 0, At, B0); G_BAR; G_SCHED;
        G_STAGE(G_SB(1, 1), b3 + hstep);
        G_WAIT_V(6); G_BAR; G_MMA(1, 1, At, B1); G_BAR;
      }
      const int brow = pm * GBM, bcol = pn * GBM;
    const int r0 = brow + wr * 64 + fr;
    if (epi == EPI_PLAIN) {
#pragma unroll
      for (int ai = 0; ai < 2; ++ai)
#pragma unroll
        for (int m = 0; m < 4; ++m) {
          bf16_t* rp = outp + (size_t)(r0 + ai * GHALF + m * 16) * N + bcol + wc * 32 + fq * 8;
#pragma unroll
          for (int bj = 0; bj < 2; ++bj) {
            const f32x4 v0 = acc[ai][bj][m][0], v1 = acc[ai][bj][m][1];
            *reinterpret_cast<u32x4*>(rp + bj * GHALF) = mk4(pk2(v0[0], v0[1]), pk2(v0[2], v0[3]), pk2(v1[0], v1[1]), pk2(v1[2], v1[3]));
          }
        }
    } else if (epi == EPI_SWIGLU) {
#pragma unroll
      for (int ai = 0; ai < 2; ++ai)
#pragma unroll
        for (int m = 0; m < 4; ++m) {
          bf16_t* rp = outp + (size_t)(r0 + ai * GHALF + m * 16) * DFF + pn * 128 + wc * 32 + fq * 8;
          unsigned pk[4];
#pragma unroll
          for (int bj = 0; bj < 2; ++bj) {
            const f32x4 g = acc[ai][bj][m][0], u = acc[ai][bj][m][1];
            const float o0 = silu_f(g[0]) * u[0], o1 = silu_f(g[1]) * u[1], o2 = silu_f(g[2]) * u[2], o3 = silu_f(g[3]) * u[3];
            pk[2 * bj] = pk2(o0, o1); pk[2 * bj + 1] = pk2(o2, o3);
          }
          *reinterpret_cast<u32x4*>(rp) = mk4(pk[0], pk[1], pk[2], pk[3]);
        }
    } else {
      if (pn < 12) {
        bf16_t* dst; int ld, c0;
        if (pn < 3) { dst = p.big; ld = 768; c0 = pn * 256; }
        else if (pn < 5) { dst = p.big + (size_t)TA * 768; ld = 512; c0 = (pn - 3) * 256; }
        else if (pn < 9) { dst = p.big + (size_t)TA * 1280; ld = 1024; c0 = (pn - 5) * 256; }
        else { dst = p.big + (size_t)TA * 2304; ld = 768; c0 = (pn - 9) * 256; }
#pragma unroll
        for (int ai = 0; ai < 2; ++ai)
#pragma unroll
          for (int m = 0; m < 4; ++m) {
            bf16_t* rp = dst + (size_t)(r0 + ai * GHALF + m * 16) * ld + c0 + wc * 32 + fq * 8;
#pragma unroll
            for (int bj = 0; bj < 2; ++bj) {
              const f32x4 v0 = acc[ai][bj][m][0], v1 = acc[ai][bj][m][1];
              *reinterpret_cast<u32x4*>(rp + bj * GHALF) = mk4(pk2(v0[0], v0[1]), pk2(v0[2], v0[3]), pk2(v1[0], v1[1]), pk2(v1[2], v1[3]));
            }
          }
      } else if (wc == 0 && fq < 2) {
        const float* db = p.dt_bias + l * 16 + fq * 8;
        float dbv[8];
#pragma unroll
        for (int i = 0; i < 8; ++i) dbv[i] = db[i];
#pragma unroll
        for (int ai = 0; ai < 2; ++ai)
#pragma unroll
          for (int m = 0; m < 4; ++m) {
            const f32x4 v0 = acc[ai][0][m][0], v1 = acc[ai][0][m][1];
            float4 o0, o1;
            o0.x = softplus_f(v0[0] + dbv[0]); o0.y = softplus_f(v0[1] + dbv[1]); o0.z = softplus_f(v0[2] + dbv[2]); o0.w = softplus_f(v0[3] + dbv[3]);
            o1.x = softplus_f(v1[0] + dbv[4]); o1.y = softplus_f(v1[1] + dbv[5]); o1.z = softplus_f(v1[2] + dbv[6]); o1.w = softplus_f(v1[3] + dbv[7]);
            float* dp = p.dtb + (size_t)(r0 + ai * GHALF + m * 16) * 16 + fq * 8;
            *reinterpret_cast<float4*>(dp) = o0;
            *reinterpret_cast<float4*>(dp + 4) = o1;
          }
      }
    }
      if (!has_next) break;
#pragma unroll
      for (int a = 0; a < 2; ++a)
#pragma unroll
        for (int b = 0; b < 2; ++b)
#pragma unroll
          for (int m = 0; m < 4; ++m)
#pragma unroll
            for (int n = 0; n < 2; ++n) acc[a][b][m][n] = zero4();
      Lw = Ln; pm = npm; pn = npn; cA = nA; cB = nB;
    }
    G_WAIT_V(0);
    if (wr == 0) G_BAR;
    G_BAR;
  }
  __syncthreads();
#undef G_SA
#undef G_SB
#undef G_STAGE
#undef G_LDA
#undef G_LDB
#undef G_MMA
#undef G_WAIT_V
#undef G_WAIT_L
#undef G_BAR
#undef G_SCHED
}

__device__ __forceinline__ void prep_filter_item(const Params& p, int l, int it, char* smem, int wvi) {
  const int tid = otid(wvi);
  int pos0, L;
  if (it < 256) { pos0 = it * 16; L = SEQ; } else { pos0 = (it - 256) * 16; L = LC; }
  const float inv_lm1 = (L == SEQ) ? (1.f / (float)(SEQ - 1)) : (1.f / (float)(LC - 1));
  const double inv_l = (L == SEQ) ? (1.0 / (double)SEQ) : (1.0 / (double)LC);
  float* sF = reinterpret_cast<float*>(smem);
  float* sH1 = sF + 16 * 33;
  float* sH2 = sH1 + 16 * 64;
  float* sH3 = sH2 + 16 * 64;
  __syncthreads();
  for (int idx = tid; idx < 16 * 33; idx += 256) {
    const int ps = idx / 33, k = idx - ps * 33;
    const int i = pos0 + ps;
    float v;
    if (k == 0) v = (float)i * inv_lm1;
    else {
      const int j = (k - 1) & 15;
      const double f = 1e-4 + (double)j * ((15.0 - 1e-4) / 15.0);
      double r = f * (double)i * inv_l;
      r -= floor(r);
      const float ang = 6.283185307179586f * (float)r;
      v = (k <= 16) ? cosf(ang) : -sinf(ang);
    }
    sF[idx] = v;
  }
  __syncthreads();
  const int u = tid & 63, pg = tid >> 6;
  const float fr = p.freq[l * 64 + u];
  {
    const float* W = p.fw1 + (size_t)l * 33 * 64; const float bb = p.fb1[l * 64 + u];
#pragma unroll 1
    for (int q = 0; q < 4; ++q) {
      const int ps = pg * 4 + q; float a = bb;
      for (int k = 0; k < 33; ++k) a += sF[ps * 33 + k] * W[k * 64 + u];
      sH1[ps * 64 + u] = sinf(fr * a);
    }
  }
  __syncthreads();
  {
    const float* W = p.fw2 + (size_t)l * 64 * 64; const float bb = p.fb2[l * 64 + u];
#pragma unroll 1
    for (int q = 0; q < 4; ++q) {
      const int ps = pg * 4 + q; float a = bb;
      for (int k = 0; k < 64; ++k) a += sH1[ps * 64 + k] * W[k * 64 + u];
      sH2[ps * 64 + u] = sinf(fr * a);
    }
  }
  __syncthreads();
  {
    const float* W = p.fw3 + (size_t)l * 64 * 64; const float bb = p.fb3[l * 64 + u];
#pragma unroll 1
    for (int q = 0; q < 4; ++q) {
      const int ps = pg * 4 + q; float a = bb;
      for (int k = 0; k < 64; ++k) a += sH2[ps * 64 + k] * W[k * 64 + u];
      sH3[ps * 64 + u] = sinf(fr * a);
    }
  }
  __syncthreads();
  const float* W4 = p.fw4 + (size_t)l * 64 * 1024;
  const float a0 = -3.0701134573253944f, a1 = -15.350567286626972f;
  for (int cc = 0; cc < 4; ++cc) {
    const int col = tid + 256 * cc;
    const int o = col >> 9, dr = (col >> 8) & 1, ch = col & 255;
    const float dl = fabsf(a0 + (float)ch * ((a1 - a0) / 255.f));
    for (int half = 0; half < 2; ++half) {
      float acc[8];
#pragma unroll
      for (int q = 0; q < 8; ++q) acc[q] = 0.f;
      for (int k = 0; k < 64; ++k) {
        const float wv = W4[k * 1024 + col];
#pragma unroll
        for (int q = 0; q < 8; ++q) acc[q] += sH3[(half * 8 + q) * 64 + k] * wv;
      }
#pragma unroll
      for (int q = 0; q < 8; ++q) {
        const int i = pos0 + half * 8 + q;
        const float t = (float)i * inv_lm1;
        const float v = acc[q] * expf(-t * dl);
        float* kb = (L == SEQ) ? p.kfl + (size_t)(o * 256 + ch) * 8192 : p.kfc + (size_t)(o * 256 + ch) * 512;
        const int mid = (L == SEQ) ? 4096 : 256;
        const int idx = (dr == 0) ? mid + i : ((i >= 1) ? mid - i : 0);
        kb[idx] = v;
      }
    }
  }
}

__device__ __forceinline__ void prep_mod_item(const Params& p, int it, char* smem, int wvi) {
  const int tid = otid(wvi), lane = tid & 63, w = tid >> 6;
  const int l2 = it / 144, col0 = (it - l2 * 144) * 64;
  float* sS = reinterpret_cast<float*>(smem);
  float* sR = sS + 17 * 256;
  float acc[17];
#pragma unroll
  for (int m = 0; m < 17; ++m) acc[m] = 0.f;
  for (int kc = 0; kc < 4; ++kc) {
    __syncthreads();
    for (int idx = tid; idx < 17 * 256; idx += 256) {
      const int m = idx >> 8, k = idx & 255;
      const float v = (m < 16) ? p.c[m * DM + kc * 256 + k] : p.c_ctx[kc * 256 + k];
      sS[idx] = v * __builtin_amdgcn_rcpf(1.f + expf(-v));
    }
    __syncthreads();
    const float* Wp = p.w_mod + ((size_t)l2 * DM + kc * 256 + w * 64) * MODROW + col0 + lane;
    for (int kk = 0; kk < 64; ++kk) {
      const float wv = Wp[(size_t)kk * MODROW];
      const float* sp = sS + w * 64 + kk;
#pragma unroll
      for (int m = 0; m < 17; ++m) acc[m] += sp[m * 256] * wv;
    }
  }
  __syncthreads();
#pragma unroll
  for (int m = 0; m < 17; ++m) sR[(w * 17 + m) * 64 + lane] = acc[m];
  __syncthreads();
  for (int idx = tid; idx < 17 * 64; idx += 256) {
    const int m = idx >> 6, cl = idx & 63;
    float s = p.b_mod[l2 * MODROW + col0 + cl];
#pragma unroll
    for (int ww = 0; ww < 4; ++ww) s += sR[(ww * 17 + m) * 64 + cl];
    p.mod[(size_t)(l2 * 17 + m) * MODROW + col0 + cl] = s;
  }
}

__device__ __forceinline__ int perm32(int rho) { const int n = rho >> 4, i = rho & 15; return 8 * (i >> 2) + 4 * n + (i & 3); }
__device__ __forceinline__ int srccol(int mode, int n) {
  if (mode == 0) return (n & ~31) + perm32(n & 31);
  if (mode == 1) {
    const int tile = n >> 8, r = n & 255, bj = r >> 7, wc = (r >> 5) & 3, q = (r >> 4) & 1, i = r & 15;
    return (q ? DFF : 0) + tile * 128 + wc * 32 + (i >> 2) * 8 + bj * 4 + (i & 3);
  }
  const int L = (n & ~31) + perm32(n & 31);
  if (L < 2304) return L;
  if (L < 3072) return L + 16;
  if (L < 3088) return L - 768;
  return -1;
}

__device__ __forceinline__ void prep_conv_item(const Params& p, int l, int it, char* smem, int wvi) {
  const int tid = otid(wvi);
  const float* src; bf16_t* dst; int ld, K, mode, KT;
  if (it < 2816) { const int i = it / 1408; it -= i * 1408; src = p.ffn_w_in + (size_t)(l * 2 + i) * DM * 2 * DFF; dst = i ? p.wFin1 : p.wFin0; ld = 2 * DFF; K = DM; mode = 1; KT = 16; }
  else if (it < 4224) { it -= 2816; const int i = it / 704; it -= i * 704; src = p.ffn_w_out + (size_t)(l * 2 + i) * DFF * DM; dst = i ? p.wFout1 : p.wFout0; ld = DM; K = DFF; mode = 0; KT = 44; }
  else if (it < 5056) { it -= 4224; src = p.w_in + (size_t)l * DM * DIN; dst = p.wIn; ld = DIN; K = DM; mode = 2; KT = 16; }
  else { it -= 5056; src = p.w_out + (size_t)l * DM * DM; dst = p.wOut; ld = DM; K = DM; mode = 0; KT = 16; }
  const int ntile = it / KT, ktile = it - ntile * KT;
  const int n0 = ntile * 64, k0 = ktile * 64;
  float* sT = reinterpret_cast<float*>(smem);
  __syncthreads();
#pragma unroll 4
  for (int i = 0; i < 16; ++i) {
    const int idx = tid + 256 * i, k = idx >> 6, n = idx & 63;
    const int sc = srccol(mode, n0 + n);
    sT[k * 65 + n] = (sc >= 0) ? src[(size_t)(k0 + k) * ld + sc] : 0.f;
  }
  __syncthreads();
#pragma unroll
  for (int i = 0; i < 2; ++i) {
    const int idx = tid + 256 * i, n = idx >> 3, kg = idx & 7;
    float f[8];
#pragma unroll
    for (int j = 0; j < 8; ++j) f[j] = sT[(kg * 8 + j) * 65 + n];
    *reinterpret_cast<u32x4*>(dst + (size_t)(n0 + n) * K + k0 + kg * 8) = pack8(f);
  }
}

__device__ __forceinline__ void prep_phase(const Params& p, int l, char* smem, int wvi, int part) {
  const int nfilt = 272, nmod = (l == 0) ? 576 : 0;
  constexpr int FOUT1_LO = 3520, FOUT1_N = 704, NCONV = 5312;
  if (part == 0) {
    const int total = nfilt + nmod + NCONV;
    for (int it = obid(wvi); it < total; it += vgrid()) {
      if (it < nfilt) prep_filter_item(p, l, it, smem, wvi);
      else if (it < nfilt + nmod) prep_mod_item(p, it - nfilt, smem, wvi);
      else prep_conv_item(p, l, it - nfilt - nmod, smem, wvi);
    }
  } else if (part == 1) {
    const int total = nfilt + NCONV - FOUT1_N;
    for (int j = obid(wvi) - 128; j < total; j += vgrid() - 128) {
      if (j < nfilt) prep_filter_item(p, l, j, smem, wvi);
      else { const int c = j - nfilt; prep_conv_item(p, l, c < FOUT1_LO ? c : c + FOUT1_N, smem, wvi); }
    }
  } else {
    for (int j = obid(wvi); j < FOUT1_N; j += vgrid()) prep_conv_item(p, l, FOUT1_LO + j, smem, wvi);
  }
}

__device__ __forceinline__ void conv_ssd_item(const Params& p, int l, int item, int wvi) {
  const int sg = item >> 2, cc = item & 3;
  const int tid = otid(wvi), cg8 = tid & 31, pc = tid >> 5;
  const int col = cc * 256 + cg8 * 8;
  int segbase, PL;
  if (sg < 1024) { segbase = sg * 64; PL = 8; } else { segbase = TL + (sg - 1024) * 256; PL = 32; }
  bf16_t* base = p.big + (size_t)TA * 1280 + (size_t)segbase * 1024 + col;
  float w0[8], w1[8], w2[8], bb[8];
  {
    const float* cw = p.ssd_conv_w + (size_t)l * 3 * 1024 + col;
    const float* cb = p.ssd_conv_b + (size_t)l * 1024 + col;
#pragma unroll
    for (int i = 0; i < 8; ++i) { w0[i] = cw[i]; w1[i] = cw[1024 + i]; w2[i] = cw[2048 + i]; bb[i] = cb[i]; }
  }
  const int r0 = pc * PL;
  const u32x4 zero = zero_u4();
  const u32x4 hprev = (pc > 0) ? *reinterpret_cast<const u32x4*>(base + (size_t)(r0 - 1) * 1024) : zero;
  const u32x4 hnext = (pc < 7) ? *reinterpret_cast<const u32x4*>(base + (size_t)(r0 + PL) * 1024) : zero;
  const u32x4 cur0 = *reinterpret_cast<const u32x4*>(base + (size_t)r0 * 1024);
  __syncthreads();
  float fp[8], fc[8], fn[8];
  unpack8(hprev, fp); unpack8(cur0, fc);
  for (int k = 0; k < PL; k += 8) {
    u32x4 rows[8];
#pragma unroll
    for (int j = 0; j < 8; ++j)
      rows[j] = (k + j + 1 < PL) ? *reinterpret_cast<const u32x4*>(base + (size_t)(r0 + k + j + 1) * 1024) : hnext;
#pragma unroll
    for (int j = 0; j < 8; ++j) {
      unpack8(rows[j], fn);
      float o[8];
#pragma unroll
      for (int i = 0; i < 8; ++i) o[i] = silu_f(w0[i] * fp[i] + w1[i] * fc[i] + w2[i] * fn[i] + bb[i]);
      *reinterpret_cast<u32x4*>(base + (size_t)(r0 + k + j) * 1024) = pack8(o);
#pragma unroll
      for (int i = 0; i < 8; ++i) { fp[i] = fc[i]; fc[i] = fn[i]; }
    }
  }
}

__device__ __forceinline__ void conv_hy_item(const Params& p, int l, int item, char* smem, int wvi) {
  const int tid = otid(wvi);
  const int pi = item / 3, part = item - pi * 3;
  int tok0; bool hasPrev = false, hasNext = false;
  if (pi < 1024) tok0 = pi * 64;
  else { const int j = pi - 1024, qq = j & 3; tok0 = TL + (j >> 2) * 256 + qq * 64; hasPrev = qq > 0; hasNext = qq < 3; }
  bf16_t* sIn = reinterpret_cast<bf16_t*>(smem);
  bf16_t* sOut = sIn + 66 * 264;
  const bf16_t* ph = p.big + part * 256;
  __syncthreads();
  for (int slot = tid; slot < 66 * 32; slot += 256) {
    const int r = slot >> 5, c8 = slot & 31;
    const bool valid = (r == 0) ? hasPrev : ((r == 65) ? hasNext : true);
    u32x4 v = zero_u4();
    if (valid) v = *reinterpret_cast<const u32x4*>(ph + (size_t)(tok0 - 1 + r) * 768 + c8 * 8);
    *reinterpret_cast<u32x4*>(sIn + r * 264 + c8 * 8) = v;
  }
  __syncthreads();
  {
    const int c = tid, ch = part * 256 + c;
    const float* cw = p.hy_conv_w + (size_t)l * 3 * 768 + ch;
    const float w0 = cw[0], w1 = cw[768], w2 = cw[1536], bb = p.hy_conv_b[l * 768 + ch];
    float a = bf2f(sIn[c]), b = bf2f(sIn[264 + c]);
#pragma unroll 8
    for (int t = 0; t < 64; ++t) {
      const float cn = bf2f(sIn[(t + 2) * 264 + c]);
      sOut[c * 66 + t] = f2bf(w0 * a + w1 * b + w2 * cn + bb);
      a = b; b = cn;
    }
  }
  __syncthreads();
#pragma unroll
  for (int i = 0; i < 4; ++i) {
    const int slot = tid + 256 * i, c = slot >> 2, q4 = slot & 3;
    const unsigned* sp = reinterpret_cast<const unsigned*>(sOut + c * 66 + q4 * 16);
    u32x4 v0 = mk4(sp[0], sp[1], sp[2], sp[3]), v1 = mk4(sp[4], sp[5], sp[6], sp[7]);
    bf16_t* dp = p.hyT + (size_t)(part * 256 + c) * TA + tok0 + q4 * 16;
    *reinterpret_cast<u32x4*>(dp) = v0;
    *reinterpret_cast<u32x4*>(dp + 8) = v1;
  }
}

__device__ __forceinline__ void shortconv_tokens(const Params& p, int l, int wvi) {
  const int tid = otid(wvi); const int lane = tid & 63, w = tid >> 6;
  const int nw = vgrid() * 4;
  const bf16_t* ps = p.big + (size_t)TA * 2304;
  const int ch = lane * 4;
  float w0[4], w1[4], w2[4], gn[4];
#pragma unroll
  for (int i = 0; i < 4; ++i) {
    w0[i] = p.sc_conv_w[l * 768 + ch + i]; w1[i] = p.sc_conv_w[l * 768 + 256 + ch + i]; w2[i] = p.sc_conv_w[l * 768 + 512 + ch + i];
    gn[i] = p.mix_gain[l * 1024 + 768 + ch + i];
  }
  const int per = (TA + nw - 1) / nw, gw = obid(wvi) * 4 + w;
  const int r0 = gw * per, r1 = min(TA, r0 + per);
  if (r0 >= r1) return;
  const u32x2 z2 = mk2(0u, 0u);
  u32x2 gcp = z2, hxp = z2, gcc, hxc, gbc, gcn = z2, hxn = z2, gbn = z2;
  if (r0 > 0) { gcp = *reinterpret_cast<const u32x2*>(ps + (size_t)(r0 - 1) * 768 + 256 + ch); hxp = *reinterpret_cast<const u32x2*>(ps + (size_t)(r0 - 1) * 768 + 512 + ch); }
  gbc = *reinterpret_cast<const u32x2*>(ps + (size_t)r0 * 768 + ch);
  gcc = *reinterpret_cast<const u32x2*>(ps + (size_t)r0 * 768 + 256 + ch);
  hxc = *reinterpret_cast<const u32x2*>(ps + (size_t)r0 * 768 + 512 + ch);
  for (int tok = r0; tok < r1; ++tok) {
    if (tok + 1 < TA) {
      const bf16_t* np = ps + (size_t)(tok + 1) * 768 + ch;
      gbn = *reinterpret_cast<const u32x2*>(np); gcn = *reinterpret_cast<const u32x2*>(np + 256); hxn = *reinterpret_cast<const u32x2*>(np + 512);
    }
    int ps_, sl;
    if (tok < TL) { ps_ = tok & 63; sl = 64; } else { ps_ = (tok - TL) & 255; sl = 256; }
    const float mp = (ps_ > 0) ? 1.f : 0.f, mn = (ps_ < sl - 1) ? 1.f : 0.f;
    float v[4];
    v[0] = lo2f(gbc.x) * (mp * w0[0] * lo2f(gcp.x) * lo2f(hxp.x) + w1[0] * lo2f(gcc.x) * lo2f(hxc.x) + mn * w2[0] * lo2f(gcn.x) * lo2f(hxn.x));
    v[1] = hi2f(gbc.x) * (mp * w0[1] * hi2f(gcp.x) * hi2f(hxp.x) + w1[1] * hi2f(gcc.x) * hi2f(hxc.x) + mn * w2[1] * hi2f(gcn.x) * hi2f(hxn.x));
    v[2] = lo2f(gbc.y) * (mp * w0[2] * lo2f(gcp.y) * lo2f(hxp.y) + w1[2] * lo2f(gcc.y) * lo2f(hxc.y) + mn * w2[2] * lo2f(gcn.y) * lo2f(hxn.y));
    v[3] = hi2f(gbc.y) * (mp * w0[3] * hi2f(gcp.y) * hi2f(hxp.y) + w1[3] * hi2f(gcc.y) * hi2f(hxc.y) + mn * w2[3] * hi2f(gcn.y) * hi2f(hxn.y));
    float ss = wave_sum(v[0] * v[0] + v[1] * v[1] + v[2] * v[2] + v[3] * v[3]);
    const float rstd = rsqrtf(ss * (1.f / 256.f) + EPS);
    *reinterpret_cast<u32x2*>(p.bufA + (size_t)tok * DM + 768 + ch) =
        mk2(pk2(v[0] * rstd * gn[0], v[1] * rstd * gn[1]), pk2(v[2] * rstd * gn[2], v[3] * rstd * gn[3]));
    gcp = gcc; hxp = hxc; gcc = gcn; hxc = hxn; gbc = gbn;
  }
}

__device__ __forceinline__ void conv_phase(const Params& p, int l, char* smem, int wvi) {
  const int n_ssd = 1040 * 4, n_hy = 1088 * 3;
  for (int it = obid(wvi); it < n_ssd; it += vgrid()) conv_ssd_item(p, l, it, wvi);
  for (int it = obid(wvi); it < n_hy; it += vgrid()) conv_hy_item(p, l, it, smem, wvi);
  shortconv_tokens(p, l, wvi);
}

typedef short s16x4 __attribute__((ext_vector_type(4)));
__device__ __forceinline__ bf16x8 tr8(const bf16_t* T, int stride, int srow0, int col0, int lane) {
  const int quad = lane >> 4, q = (lane & 15) >> 2, pp = lane & 3;
  const bf16_t* a0 = T + (srow0 + 8 * quad + q) * stride + col0 + 4 * pp;
  const s16x4 lo = __builtin_amdgcn_ds_read_tr16_b64_v4i16((GLAS s16x4*)a0);
  const s16x4 hi = __builtin_amdgcn_ds_read_tr16_b64_v4i16((GLAS s16x4*)(a0 + 4 * stride));
  return (bf16x8){lo[0], lo[1], lo[2], lo[3], hi[0], hi[1], hi[2], hi[3]};
}
__device__ __forceinline__ float bperm_f(int src_lane, float v) { return __int_as_float(__builtin_amdgcn_ds_bpermute(src_lane << 2, __float_as_int(v))); }

__device__ __forceinline__ void ssd_scan_item(const Params& p, int l, int item, char* smem, int wvi) {
  const int tid = otid(wvi), lane = tid & 63, w = tid >> 6, l16 = lane & 15, quad = lane >> 4;
  const int wg_ = item >> 1, xcd_ = wg_ & 7, k_ = wg_ >> 3, j_ = k_ & 7, G_ = (k_ >> 3) * 8 + xcd_;
  const int ph = item & 1, dir = j_ & 1, b = G_ >> 1, g = G_ & 1, h = g * 4 + (j_ >> 1);
  const bool last = (l == DEPTH - 1);
  bf16_t* sC = reinterpret_cast<bf16_t*>(smem);
  bf16_t* sB = sC + 64 * 136;
  bf16_t* sXd = sB + 64 * 136;
  bf16_t* sXw = sXd + 64 * 36;
  bf16_t* sM = sXw + 64 * 36;
  bf16_t* sH0 = sM + 64 * 72;
  float* sAcsW = reinterpret_cast<float*>(sH0 + 2 * 32 * 136) + w * 64;
  const bf16_t* pxbc = p.big + (size_t)TA * 1280;
  bf16_t* ydir = p.bufB + (size_t)dir * TA * 512;
  const float aco = -expf(p.a_log[l * 16 + dir * 8 + h]);

  __syncthreads();
  for (int i = tid; i < 2 * 32 * 136 / 8; i += 256) reinterpret_cast<u32x4*>(sH0)[i] = zero_u4();
  f32x4 hacc[2][2];
#pragma unroll
  for (int a = 0; a < 2; ++a)
#pragma unroll
    for (int c = 0; c < 2; ++c) hacc[a][c] = zero4();

  u32x4 rc[4], rb[4], rx; float rdt = 0.f;
  auto chunk_base = [&](int step) -> int {
    if (step < 4) { const int ck = dir ? 3 - step : step; return TL + b * 256 + ck * 64; }
    const int s2 = step - 4; const int ck = dir ? 63 - s2 : s2; return b * 4096 + ck * 64;
  };
  unsigned roff[4]; unsigned xoff, doff;
#pragma unroll
  for (int i = 0; i < 4; ++i) {
    const int slot = tid + 256 * i, row = slot >> 4, c8 = slot & 15;
    roff[i] = (unsigned)((dir ? 63 - row : row) * 1024 + g * 128 + c8 * 8);
  }
  { const int row = tid >> 2, c8 = tid & 3; xoff = (unsigned)((dir ? 63 - row : row) * 1024 + h * 64 + ph * 32 + c8 * 8); }
  doff = (unsigned)((dir ? 63 - lane : lane) * 16 + dir * 8 + h);
  auto issue = [&](int step) {
    const int base = chunk_base(step);
    const bf16_t* cb = pxbc + (size_t)base * 1024;
    const float* db = p.dtb + (size_t)base * 16;
#pragma unroll
    for (int i = 0; i < 4; ++i) {
      rb[i] = *reinterpret_cast<const u32x4*>(cb + 512 + roff[i]);
      rc[i] = *reinterpret_cast<const u32x4*>(cb + 768 + roff[i]);
    }
    rx = *reinterpret_cast<const u32x4*>(cb + xoff);
    rdt = db[doff];
  };
  issue(0);
  const int lidx = 16 * w + l16;
  const unsigned yoff = (unsigned)((dir ? 63 - lidx : lidx) * 512 + h * 64 + ph * 32 + quad * 4);
  float acs = rdt * aco;
#pragma unroll
  for (int o = 1; o < 64; o <<= 1) { const float t = bperm_f(lane - o, acs); acs += (lane >= o) ? t : 0.f; }
  for (int step = 0; step < 68; ++step) {
    const int base = chunk_base(step);
    const bf16_t* sH = sH0 + (step & 1) * (32 * 136);
    bf16_t* sHn = sH0 + ((step + 1) & 1) * (32 * 136);
    __syncthreads();
#pragma unroll
    for (int i = 0; i < 4; ++i) {
      const int slot = tid + 256 * i, row = slot >> 4, c8 = slot & 15;
      *reinterpret_cast<u32x4*>(sC + row * 136 + c8 * 8) = rc[i];
      *reinterpret_cast<u32x4*>(sB + row * 136 + c8 * 8) = rb[i];
    }
    const float dt_cur = rdt;
    const float Atot = __int_as_float(__builtin_amdgcn_readlane(__float_as_int(acs), 63));
    sAcsW[lane] = acs;
    {
      const int row = tid >> 2, c8 = tid & 3;
      const float acs_r = bperm_f(row, acs), dtv = bperm_f(row, dt_cur);
      const float wv = __expf(Atot - acs_r);
      float f[8]; unpack8(rx, f);
      u32x2* d0 = reinterpret_cast<u32x2*>(sXd + row * 36 + c8 * 8);
      u32x2* d1 = reinterpret_cast<u32x2*>(sXw + row * 36 + c8 * 8);
      float a[8];
#pragma unroll
      for (int i = 0; i < 8; ++i) a[i] = f[i] * dtv;
      d0[0] = mk2(pk2(a[0], a[1]), pk2(a[2], a[3])); d0[1] = mk2(pk2(a[4], a[5]), pk2(a[6], a[7]));
      d1[0] = mk2(pk2(a[0] * wv, a[1] * wv), pk2(a[2] * wv, a[3] * wv)); d1[1] = mk2(pk2(a[4] * wv, a[5] * wv), pk2(a[6] * wv, a[7] * wv));
    }
    if (step + 1 < 68) issue(step + 1);
    __syncthreads();
    bf16x8 cfr[4];
#pragma unroll
    for (int kk = 0; kk < 4; ++kk) cfr[kk] = ldfrag(sC + lidx * 136 + kk * 32 + quad * 8);
    const float al = sAcsW[lidx];
    {
#pragma unroll
      for (int st = 0; st < 4; ++st) {
        float m[4];
        {
          f32x4 acc = zero4();
#pragma unroll
          for (int kk = 0; kk < 4; ++kk) acc = mfma16(ldfrag(sB + (16 * st + l16) * 136 + kk * 32 + quad * 8), cfr[kk], acc);
          const float4 as4 = *reinterpret_cast<const float4*>(sAcsW + 16 * st + quad * 4);
          const float asj[4] = {as4.x, as4.y, as4.z, as4.w};
#pragma unroll
          for (int j = 0; j < 4; ++j) {
            const int s = 16 * st + quad * 4 + j;
            const float msk = (s <= lidx) ? 1.f : 0.f;
            m[j] = acc[j] * __expf(fminf(al - asj[j], 0.f)) * msk;
          }
        }
        *reinterpret_cast<u32x2*>(sM + lidx * 72 + 16 * st + quad * 4) = mk2(pk2(m[0], m[1]), pk2(m[2], m[3]));
      }
    }
    {
      const float el = __expf(al);
      bf16_t* yb_ = ydir + (size_t)base * 512;
      bf16x8 mfr[2];
      mfr[0] = ldfrag(sM + lidx * 72 + quad * 8);
      mfr[1] = ldfrag(sM + lidx * 72 + 32 + quad * 8);
#pragma unroll
      for (int pt = 0; pt < 2; ++pt) {
        f32x4 acc = zero4();
#pragma unroll
        for (int kk = 0; kk < 4; ++kk) acc = mfma16(ldfrag(sH + (16 * pt + l16) * 136 + kk * 32 + quad * 8), cfr[kk], acc);
        acc[0] *= el; acc[1] *= el; acc[2] *= el; acc[3] *= el;
        acc = mfma16(tr8(sXd, 36, 0, 16 * pt, lane), mfr[0], acc);
        acc = mfma16(tr8(sXd, 36, 32, 16 * pt, lane), mfr[1], acc);
        *reinterpret_cast<u32x2*>(yb_ + yoff + 16 * pt) =
              mk2(pk2(acc[0], acc[1]), pk2(acc[2], acc[3]));
      }
    }
    {
      const float eT = __expf(Atot);
#pragma unroll
      for (int a = 0; a < 2; ++a)
#pragma unroll
        for (int c = 0; c < 2; ++c) { hacc[a][c][0] *= eT; hacc[a][c][1] *= eT; hacc[a][c][2] *= eT; hacc[a][c][3] *= eT; }
#pragma unroll
      for (int kk = 0; kk < 2; ++kk) {
        bf16x8 af[2], bq[2];
#pragma unroll
        for (int nti = 0; nti < 2; ++nti) af[nti] = tr8(sB, 136, 32 * kk, 16 * (2 * w + nti), lane);
#pragma unroll
        for (int pt = 0; pt < 2; ++pt) bq[pt] = tr8(sXw, 36, 32 * kk, 16 * pt, lane);
#pragma unroll
        for (int nti = 0; nti < 2; ++nti)
#pragma unroll
          for (int pt = 0; pt < 2; ++pt) hacc[nti][pt] = mfma16(af[nti], bq[pt], hacc[nti][pt]);
      }
#pragma unroll
      for (int nti = 0; nti < 2; ++nti)
#pragma unroll
        for (int pt = 0; pt < 2; ++pt) {
          const f32x4 v = hacc[nti][pt];
          *reinterpret_cast<u32x2*>(sHn + (16 * pt + l16) * 136 + 16 * (2 * w + nti) + quad * 4) = mk2(pk2(v[0], v[1]), pk2(v[2], v[3]));
        }
      float nacs = rdt * aco;
#pragma unroll
      for (int o = 1; o < 64; o <<= 1) { const float t = bperm_f(lane - o, nacs); nacs += (lane >= o) ? t : 0.f; }
      acs = nacs;
    }
  }
}

__device__ __forceinline__ void ssd_combine_tokens(const Params& p, int l, int rows, int wvi) {
  const int tid = otid(wvi); const int lane = tid & 63, w = tid >> 6;
  const int nw = vgrid() * 4;
  const int ch = lane * 8;
  const float Dv = p.ssd_d[l * 8 + (lane >> 3)];
  float gn[8];
#pragma unroll
  for (int i = 0; i < 8; ++i) gn[i] = p.mix_gain[l * 1024 + 256 + ch + i];
  const bf16_t* pz = p.big + (size_t)TA * 768;
  const bf16_t* pxbc = p.big + (size_t)TA * 1280;
  const int per = (rows + nw - 1) / nw, gw = obid(wvi) * 4 + w;
  const int r0 = gw * per, r1 = min(rows, r0 + per);
  if (r0 >= r1) return;
  u32x4 nyf, nyb, nxs, nzz;
  auto fetch = [&](int tok) {
    nyf = *reinterpret_cast<const u32x4*>(p.bufB + (size_t)tok * 512 + ch);
    nyb = *reinterpret_cast<const u32x4*>(p.bufB + (size_t)TA * 512 + (size_t)tok * 512 + ch);
    nxs = *reinterpret_cast<const u32x4*>(pxbc + (size_t)tok * 1024 + ch);
    nzz = *reinterpret_cast<const u32x4*>(pz + (size_t)tok * 512 + ch);
  };
  fetch(r0);
  for (int tok = r0; tok < r1; ++tok) {
    float yf[8], yb[8], xs[8], zz[8], v[8];
    unpack8(nyf, yf); unpack8(nyb, yb); unpack8(nxs, xs); unpack8(nzz, zz);
    if (tok + 1 < r1) fetch(tok + 1);
    float ss = 0.f;
#pragma unroll
    for (int i = 0; i < 8; ++i) { v[i] = (yf[i] + yb[i] + Dv * xs[i]) * silu_f(zz[i]); ss += v[i] * v[i]; }
    ss = wave_sum(ss);
    const float rstd = rsqrtf(ss * (1.f / 512.f) + EPS);
#pragma unroll
    for (int i = 0; i < 8; ++i) v[i] *= rstd * gn[i];
    *reinterpret_cast<u32x4*>(p.bufA + (size_t)tok * DM + 256 + ch) = pack8(v);
  }
}

__device__ __forceinline__ void hy_lat_item(const Params& p, int l, int o, int item, char* smem, int wvi) {
  const int tid = otid(wvi), lane = tid & 63, w = tid >> 6, l16 = lane & 15, quad = lane >> 4;
  const int c = item >> 2, bg = item & 3;
  bf16_t* sE = reinterpret_cast<bf16_t*>(smem);
  bf16_t* sO = sE + 8192 + 32;
  bf16_t* sZ = sO + 8192 + 32;
  const float* kf = p.kfl + (size_t)(o * 256 + c) * 8192;
  bf16_t* zrow = p.hyT + (size_t)c * TA;
  const bf16_t* grow = p.hyT + (size_t)((o + 1) * 256 + c) * TA;
  __syncthreads();
  for (int q = tid; q < 8192; q += 256) {
    const bf16_t r = (q == 0) ? (bf16_t)0 : f2bf(kf[8192 - q]);
    sE[q] = r;
    if (q >= 1) sO[q - 1] = r;
  }
  if (tid == 0) sO[8191] = 0;
  if (tid < 36) reinterpret_cast<unsigned*>(sZ + 4 * 4608)[tid] = 0u;
#pragma unroll
  for (int i = 0; i < 8; ++i) {
    const int slot = tid + 256 * i, bl = slot >> 9, s = (slot & 511) * 8;
    const u32x4 v = *reinterpret_cast<const u32x4*>(zrow + (size_t)(bg * 4 + bl) * SEQ + s);
    *reinterpret_cast<u32x4*>(sZ + bl * 4608 + (s >> 6) * 72 + (s & 63)) = v;
  }
  __syncthreads();
  f32x4 acc[4][4];
#pragma unroll
  for (int a = 0; a < 4; ++a)
#pragma unroll
    for (int b2 = 0; b2 < 4; ++b2) acc[a][b2] = zero4();
  const bf16_t* zw = sZ + w * 4608;
  auto ldG = [&](const bf16_t* cp, int q0) -> bf16x8 {
    const unsigned* pp = reinterpret_cast<const unsigned*>(cp + q0);
    u32x4 t = {pp[0], pp[1], pp[2], pp[3]};
    return __builtin_bit_cast(bf16x8, t);
  };
  const bf16_t* cE = sE;
  const bf16_t* cO = sO - 2;
  const int qb = 4096 - 2 * l16 + 8 * quad;
  bf16x8 e_p32 = ldG(cE, qb + 64 * 63 + 32), e_0 = ldG(cE, qb + 64 * 63), e_m32 = ldG(cE, qb + 64 * 63 - 32);
  bf16x8 o_p32 = ldG(cO, qb + 64 * 63 + 32), o_0 = ldG(cO, qb + 64 * 63), o_m32 = ldG(cO, qb + 64 * 63 - 32);
  const bf16_t* zrow0 = sZ + 4 * 4608;
  bf16x8 bcur[4][2], bnxt[4][2];
  auto ldB = [&](int d1v, bf16x8 (&bd)[4][2]) {
#pragma unroll
    for (int nt = 0; nt < 4; ++nt) {
      const int s1 = 16 * nt + l16 - d1v;
      const bf16_t* bp = ((unsigned)s1 < 64u) ? (zw + s1 * 72) : zrow0;
      bd[nt][0] = ldfrag(bp + 8 * quad);
      bd[nt][1] = ldfrag(bp + 32 + 8 * quad);
    }
  };
  ldB(-63, bcur);
#define HY_SEG(D0, D1, NT0, NT1) \
  _Pragma("unroll 1") for (int d1 = (D0); d1 <= (D1); ++d1) { \
    const int dn = (d1 < 63) ? d1 + 1 : 63; \
    const int qn = qb - 64 * dn; \
    const bf16x8 ne0 = ldG(cE, qn), nem = ldG(cE, qn - 32), no0 = ldG(cO, qn), nom = ldG(cO, qn - 32); \
    ldB(dn, bnxt); \
    _Pragma("unroll") for (int nt = (NT0); nt <= (NT1); ++nt) { \
      acc[0][nt] = mfma16(e_0, bcur[nt][0], acc[0][nt]);   acc[1][nt] = mfma16(o_0, bcur[nt][0], acc[1][nt]); \
      acc[2][nt] = mfma16(e_m32, bcur[nt][0], acc[2][nt]); acc[3][nt] = mfma16(o_m32, bcur[nt][0], acc[3][nt]); \
      acc[0][nt] = mfma16(e_p32, bcur[nt][1], acc[0][nt]); acc[1][nt] = mfma16(o_p32, bcur[nt][1], acc[1][nt]); \
      acc[2][nt] = mfma16(e_0, bcur[nt][1], acc[2][nt]);   acc[3][nt] = mfma16(o_0, bcur[nt][1], acc[3][nt]); \
    } \
    e_p32 = e_m32; o_p32 = o_m32; e_0 = ne0; e_m32 = nem; o_0 = no0; o_m32 = nom; \
    _Pragma("unroll") for (int nt = 0; nt < 4; ++nt) { bcur[nt][0] = bnxt[nt][0]; bcur[nt][1] = bnxt[nt][1]; } \
  }
  HY_SEG(-63, -48, 0, 0)
  HY_SEG(-47, -32, 0, 1)
  HY_SEG(-31, -16, 0, 2)
  HY_SEG(-15, 15, 0, 3)
  HY_SEG(16, 31, 1, 3)
  HY_SEG(32, 47, 2, 3)
  HY_SEG(48, 63, 3, 3)
#undef HY_SEG
  const float bias = p.hy_bias[l * 512 + o * 256 + c];
  const int bglob = bg * 4 + w;
#pragma unroll
  for (int h = 0; h < 2; ++h)
#pragma unroll
    for (int nt = 0; nt < 4; ++nt) {
      const int t1 = 16 * nt + l16;
      const f32x4 ye = acc[2 * h][nt], yo = acc[2 * h + 1][nt];
#pragma unroll
      for (int j = 0; j < 4; ++j) {
        const int t2 = 32 * h + 2 * (4 * quad + j);
        const unsigned zo = *reinterpret_cast<const unsigned*>(zw + t1 * 72 + t2);
        const size_t gi = (size_t)bglob * SEQ + t1 * 64 + t2;
        const unsigned gt = *reinterpret_cast<const unsigned*>(grow + gi);
        const float r0 = lo2f(gt) * (ye[j] + bias * lo2f(zo)), r1 = hi2f(gt) * (yo[j] + bias * hi2f(zo));
        *reinterpret_cast<unsigned*>(zrow + gi) = pk2(r0, r1);
      }
    }
}

__device__ __forceinline__ void hy_ctx_item(const Params& p, int l, int o, int item, char* smem, int wvi) {
  const int tid = otid(wvi);
  const int c = item >> 1, bh = item & 1;
  float* sK = reinterpret_cast<float*>(smem);
  float* sZc = sK + 512;
  const float* kf = p.kfc + (size_t)(o * 256 + c) * 512;
  bf16_t* zrow = p.hyT + (size_t)c * TA + TL + bh * 2048;
  const bf16_t* grow = p.hyT + (size_t)((o + 1) * 256 + c) * TA + TL + bh * 2048;
  __syncthreads();
  for (int i = tid; i < 512; i += 256) sK[i] = (i >= 1) ? kf[i] : 0.f;
  for (int i = tid; i < 2048; i += 256) sZc[(i >> 8) * 257 + (i & 255)] = bf2f(zrow[i]);
  __syncthreads();
  const int b = tid >> 5, tq = tid & 31;
  float acc[8];
#pragma unroll
  for (int i = 0; i < 8; ++i) acc[i] = 0.f;
  float tw[8];
#pragma unroll
  for (int i = 0; i < 8; ++i) tw[i] = sK[256 + tq * 8 + i];
#pragma unroll 8
  for (int s = 0; s < 256; ++s) {
    const float zv = sZc[b * 257 + s];
#pragma unroll
    for (int i = 0; i < 8; ++i) acc[i] += tw[i] * zv;
#pragma unroll
    for (int i = 7; i > 0; --i) tw[i] = tw[i - 1];
    tw[0] = sK[(256 + tq * 8 - s - 1) & 511];
  }
  const float bias = p.hy_bias[l * 512 + o * 256 + c];
  float res[8];
#pragma unroll
  for (int i = 0; i < 8; ++i) {
    const int t = tq * 8 + i;
    res[i] = bf2f(grow[b * 256 + t]) * (acc[i] + bias * sZc[b * 257 + t]);
  }
  __syncthreads();
  *reinterpret_cast<u32x4*>(zrow + b * 256 + tq * 8) = pack8(res);
}

__device__ __forceinline__ void hy_final_item(const Params& p, int l, int pi, char* smem, int wvi) {
  const int tid = otid(wvi), lane = tid & 63, w = tid >> 6;
  const int tok0 = pi * 64;
  bf16_t* sZ = reinterpret_cast<bf16_t*>(smem);
  float* sRed = reinterpret_cast<float*>(sZ + 256 * 66);
  float* sRs = sRed + 256;
  __syncthreads();
#pragma unroll
  for (int i = 0; i < 8; ++i) {
    const int slot = tid + 256 * i, c = slot >> 3, part = slot & 7;
    const u32x4 v = *reinterpret_cast<const u32x4*>(p.hyT + (size_t)c * TA + tok0 + part * 8);
    unsigned* d = reinterpret_cast<unsigned*>(sZ + c * 66 + part * 8);
    d[0] = v.x; d[1] = v.y; d[2] = v.z; d[3] = v.w;
  }
  __syncthreads();
  {
    const int t = tid & 63, qd = tid >> 6;
    float ss = 0.f;
    for (int c = qd * 64; c < qd * 64 + 64; ++c) { const float v = bf2f(sZ[c * 66 + t]); ss += v * v; }
    sRed[qd * 64 + t] = ss;
  }
  __syncthreads();
  if (tid < 64) sRs[tid] = rsqrtf((sRed[tid] + sRed[64 + tid] + sRed[128 + tid] + sRed[192 + tid]) * (1.f / 256.f) + EPS);
  __syncthreads();
  const int ch = lane * 4;
  float gn[4];
#pragma unroll
  for (int i = 0; i < 4; ++i) gn[i] = p.mix_gain[l * 1024 + ch + i];
  for (int tt = 0; tt < 16; ++tt) {
    const int t = w * 16 + tt; const float rs = sRs[t];
    const float v0 = bf2f(sZ[(ch + 0) * 66 + t]) * rs * gn[0], v1 = bf2f(sZ[(ch + 1) * 66 + t]) * rs * gn[1];
    const float v2 = bf2f(sZ[(ch + 2) * 66 + t]) * rs * gn[2], v3 = bf2f(sZ[(ch + 3) * 66 + t]) * rs * gn[3];
    *reinterpret_cast<u32x2*>(p.bufA + (size_t)(tok0 + t) * DM + ch) = mk2(pk2(v0, v1), pk2(v2, v3));
  }
}

constexpr int NPHASES = 2 + 13 * DEPTH;

__device__ __forceinline__ void run_phase(const Params& p, int ph, char* smem0, int wvi) {
  char* smem = smem0 + (wvi >> 2) * HALF_LDS;
  if (ph == 0) { prep_phase(p, 0, smem, wvi, 0); return; }
  NormCfg cf;
  if (ph == 1) {
    cf.src_lat = p.x; cf.src_ctx = p.ctx; cf.xs = p.xs; cf.out32 = nullptr; cf.y = nullptr; cf.g_post = nullptr; cf.mod_post = nullptr;
    cf.gate_i = 0; cf.res_w = 0.f; cf.g_pre = p.norm_g; cf.mod_pre = p.mod; cf.shift_i = 0; cf.h = p.bufA; cf.rows = TA;
    norm_phase(cf, wvi); return;
  }
  const int l = (ph - 2) / 13, s = (ph - 2) - l * 13;
  const bool last = (l == DEPTH - 1);
  const float* g = p.norm_g + (size_t)l * 6 * DM;
  const float* modl = p.mod + (size_t)l * MODLAYER;
  const float* xs_lat = (l == 0 && s <= 2) ? p.x : nullptr;
  const float* xs_ctx = (l == 0 && s <= 2) ? p.ctx : nullptr;
  switch (s) {
    case 0: gemm_phase(p, l, p.bufA, p.wFin0, TA, 2 * DFF, DM, EPI_SWIGLU, p.big, smem0, wvi); break;
    case 1: gemm_phase(p, l, p.big, p.wFout0, TA, DM, DFF, EPI_PLAIN, p.bufB, smem0, wvi); break;
    case 2:
      cf.src_lat = xs_lat; cf.src_ctx = xs_ctx; cf.xs = p.xs; cf.out32 = nullptr; cf.y = p.bufB; cf.g_post = g + DM; cf.mod_post = modl;
      cf.gate_i = 2; cf.res_w = 0.5f; cf.g_pre = g + 2 * DM; cf.mod_pre = modl; cf.shift_i = 3; cf.h = p.bufA; cf.rows = TA;
      norm_phase(cf, wvi); break;
    case 3: gemm_phase(p, l, p.bufA, p.wIn, TA, 3328, DM, EPI_INPROJ, nullptr, smem0, wvi); break;
    case 4: conv_phase(p, l, smem, wvi); break;
    case 5: {
      for (int it = obid(wvi); it < 512; it += vgrid()) ssd_scan_item(p, l, it, smem, wvi);
      const int nctx = last ? 0 : 512;
      for (int it = obid(wvi); it < 1024 + nctx; it += vgrid()) {
        if (it < nctx) hy_ctx_item(p, l, 0, it, smem, wvi); else hy_lat_item(p, l, 0, it - nctx, smem, wvi);
      }
    } break;
    case 6: {
      const int nctx = last ? 0 : 512;
      for (int it = obid(wvi); it < 1024 + nctx; it += vgrid()) {
        if (it < nctx) hy_ctx_item(p, l, 1, it, smem, wvi); else hy_lat_item(p, l, 1, it - nctx, smem, wvi);
      }
      ssd_combine_tokens(p, l, last ? TL : TA, wvi);
    } break;
    case 7: {
      const int np = last ? 1024 : 1088;
      for (int it = obid(wvi); it < np; it += vgrid()) hy_final_item(p, l, it, smem, wvi);
    } break;
    case 8: gemm_phase(p, l, p.bufA, p.wOut, last ? TL : TA, DM, DM, EPI_PLAIN, p.bufB, smem0, wvi); break;
    case 9:
      cf.src_lat = nullptr; cf.src_ctx = nullptr; cf.xs = p.xs; cf.out32 = nullptr; cf.y = p.bufB; cf.g_post = g + 3 * DM; cf.mod_post = modl;
      cf.gate_i = 5; cf.res_w = 1.0f; cf.g_pre = g + 4 * DM; cf.mod_pre = modl; cf.shift_i = 6; cf.h = p.bufA; cf.rows = last ? TL : TA;
      norm_phase(cf, wvi); break;
    case 10: gemm_phase(p, l, p.bufA, p.wFin1, last ? TL : TA, 2 * DFF, DM, EPI_SWIGLU, p.big, smem0, wvi); break;
    case 11:
      gemm_phase(p, l, p.big, p.wFout1, last ? TL : TA, DM, DFF, EPI_PLAIN, p.bufB, smem0, wvi);
      if (!last && blockIdx.x >= 64) prep_phase(p, l + 1, smem, wvi, 1);
      break;
    case 12:
      cf.src_lat = nullptr; cf.src_ctx = nullptr; cf.xs = p.xs; cf.out32 = last ? p.out : nullptr; cf.y = p.bufB; cf.g_post = g + 5 * DM; cf.mod_post = modl;
      cf.gate_i = 8; cf.res_w = 0.5f; cf.rows = last ? TL : TA;
      if (!last) { cf.g_pre = g + 6 * DM; cf.mod_pre = modl + MODLAYER; cf.shift_i = 0; cf.h = p.bufA; }
      else { cf.g_pre = nullptr; cf.mod_pre = nullptr; cf.shift_i = 0; cf.h = nullptr; }
      norm_phase(cf, wvi);
      if (!last) prep_phase(p, l + 1, smem, wvi, 2);
      break;
  }
}


#define XB_TMO      128
#define XB_XCNT(j)  (256  + 64 * (j))
#define XB_XSUB(j)  (1280 + 64 * (j))
#define XB_XGEN(j)  (2304 + 64 * (j))
#define XB_TOP      3328
#define XB_TOPGEN   3392
#define XCD_BAR_WORDS 3456
#define XB_SPIN_CAP (1u << 18)
__device__ __forceinline__ unsigned xb_ld(unsigned* p)              { return __hip_atomic_load(p, __ATOMIC_RELAXED, __HIP_MEMORY_SCOPE_AGENT); }
__device__ __forceinline__ unsigned xb_add(unsigned* p, unsigned v) { return __hip_atomic_fetch_add(p, v, __ATOMIC_RELAXED, __HIP_MEMORY_SCOPE_AGENT); }
__device__ __forceinline__ unsigned xb_xcc_id() { return (unsigned)__builtin_amdgcn_s_getreg((3 << 11) | 20) & 0xFu; }
#define XB_SPIN(cond, bar) do { unsigned _sp = 0; while (cond) { __builtin_amdgcn_s_sleep(1); \
    if ((++_sp & 255u) == 0u) { if (xb_ld(&(bar)[XB_TMO])) break; if (_sp > XB_SPIN_CAP) { atomicAdd(&(bar)[XB_TMO], 1u); break; } } } } while (0)
struct XcdBarrier { unsigned* bar; unsigned x; volatile GLAS unsigned* st; };
__device__ __forceinline__ void xcd_barrier_complete(unsigned* bar, unsigned x, unsigned& nloc, unsigned& nx) {
  const unsigned G = gridDim.x * gridDim.y * gridDim.z;
  unsigned sum, cnt, mine, sp = 0u;
  for (;;) {
    sum = 0u; cnt = 0u; mine = 0u;
#pragma unroll
    for (unsigned j = 0; j < 16; ++j) { const unsigned c = xb_ld(&bar[XB_XCNT(j)]); sum += c; cnt += (c > 0u) ? 1u : 0u; mine = (j == x) ? c : mine; }
    if (sum == G) break;
    __builtin_amdgcn_s_sleep(1);
    if ((++sp & 255u) == 0u) { if (xb_ld(&bar[XB_TMO])) break; if (sp > XB_SPIN_CAP) { atomicAdd(&bar[XB_TMO], 1u); break; } }
  }
  nloc = mine > 0u ? mine : 1u; nx = cnt > 0u ? cnt : 1u;
}
__device__ __forceinline__ void xcd_barrier(unsigned* bar_, volatile GLAS unsigned* st_, int wvi) {
  asm volatile("s_waitcnt vmcnt(0)" ::: "memory");
  __syncthreads();
  if (wvi == 0 && lane_id() == 0) {
    XcdBarrier b; b.bar = bar_; b.x = xb_xcc_id(); b.st = st_;
    unsigned* bar = b.bar;
    __builtin_amdgcn_s_waitcnt(0);
    unsigned nloc = b.st[0], nx = b.st[1];
    if (nloc == 0u) { xcd_barrier_complete(bar, b.x, nloc, nx); b.st[0] = nloc; b.st[1] = nx; }
    const unsigned old = xb_add(&bar[XB_XSUB(b.x)], 1u);
    const unsigned gen = old / nloc;
    if (old + 1u == (gen + 1u) * nloc) {
      __builtin_amdgcn_fence(__ATOMIC_RELEASE, "agent");
      asm volatile("s_waitcnt vmcnt(0)" ::: "memory");
      const unsigned og = xb_add(&bar[XB_TOP], 1u);
      const unsigned tg = og / nx;
      if (og + 1u == (tg + 1u) * nx) xb_add(&bar[XB_TOPGEN], 1u);
      else XB_SPIN(xb_ld(&bar[XB_TOPGEN]) == tg, bar);
      __builtin_amdgcn_fence(__ATOMIC_ACQUIRE, "agent");
      xb_add(&bar[XB_XGEN(b.x)], 1u);
      asm volatile("s_waitcnt vmcnt(0)" ::: "memory");
    } else {
      XB_SPIN(xb_ld(&bar[XB_XGEN(b.x)]) == gen, bar);
      __builtin_amdgcn_fence(__ATOMIC_ACQUIRE, "agent");
      asm volatile("s_waitcnt vmcnt(0)" ::: "memory");
    }
  }
  __syncthreads();
}

__global__ void __launch_bounds__(512) mega(Params p) {
  extern __shared__ __attribute__((aligned(16))) char smem[];
  cg::grid_group grid = cg::this_grid();
  const int wvi = __builtin_amdgcn_readfirstlane((int)(threadIdx.x >> 6));
  volatile GLAS unsigned* st = (volatile GLAS unsigned*)(smem + LDS_BYTES);
  if (threadIdx.x == 0) { st[0] = 0u; st[1] = 0u; st[2] = 0u; st[3] = 0u; (void)xb_add(&p.bar[XB_XCNT(xb_xcc_id())], 1u); }
  __syncthreads();
  for (int ph = p.ph_lo; ph < p.ph_hi; ++ph) {
    run_phase(p, ph, smem, wvi);
    if (ph + 1 < p.ph_hi) {
      if (ph == p.ph_lo) grid.sync();
      else xcd_barrier(p.bar, (volatile GLAS unsigned*)(smem + LDS_BYTES), wvi);
    }
  }
}

extern "C" void kernel_launch(void* const* d_in, const int* in_sizes, int n_in, void* d_out, int out_size, void* d_ws, size_t ws_size,
                              hipStream_t stream) {
  static int grid_blocks = 0;
  if (!grid_blocks) {
    int dev = 0, cus = 0, per_cu = 0;
    hipGetDevice(&dev);
    hipDeviceGetAttribute(&cus, hipDeviceAttributeMultiprocessorCount, dev);
    hipFuncSetAttribute((const void*)mega, hipFuncAttributeMaxDynamicSharedMemorySize, LDS_TOTAL);
    hipOccupancyMaxActiveBlocksPerMultiprocessor(&per_cu, (const void*)mega, 512, LDS_TOTAL);
    if (per_cu < 1) per_cu = 1;
    if (per_cu > 1) per_cu = 1;
    grid_blocks = cus * per_cu;
    fprintf(stderr, "kernel_launch: cus %d per_cu %d grid %d ws %zu\n", cus, per_cu, grid_blocks, ws_size);
  }
  Params p;
  memset(&p, 0, sizeof(p));
  const float* const* in = reinterpret_cast<const float* const*>(d_in);
  p.x = in[0]; p.c = in[1]; p.ctx = in[2]; p.c_ctx = in[3]; p.w_mod = in[4]; p.b_mod = in[5]; p.norm_g = in[6];
  p.ffn_w_in = in[7]; p.ffn_w_out = in[8]; p.w_in = in[9]; p.w_out = in[10]; p.hy_conv_w = in[11]; p.hy_conv_b = in[12];
  p.fw1 = in[13]; p.fb1 = in[14]; p.fw2 = in[15]; p.fb2 = in[16]; p.fw3 = in[17]; p.fb3 = in[18]; p.fw4 = in[19];
  p.freq = in[20]; p.hy_bias = in[21]; p.ssd_conv_w = in[22]; p.ssd_conv_b = in[23]; p.a_log = in[24]; p.dt_bias = in[25];
  p.ssd_d = in[26]; p.sc_conv_w = in[27]; p.mix_gain = in[28];
  p.out = reinterpret_cast<float*>(d_out);
  char* ws = reinterpret_cast<char*>(d_ws);
  size_t off = 0;
  auto take = [&](size_t bytes) -> char* { char* r = ws + off; off += (bytes + 255) & ~(size_t)255; return r; };
  p.wFin0 = (bf16_t*)take((size_t)2 * DFF * DM * 2);
  p.wFin1 = (bf16_t*)take((size_t)2 * DFF * DM * 2);
  p.wFout0 = (bf16_t*)take((size_t)DM * DFF * 2);
  p.wFout1 = (bf16_t*)take((size_t)DM * DFF * 2);
  p.wIn = (bf16_t*)take((size_t)3328 * DM * 2);
  p.wOut = (bf16_t*)take((size_t)DM * DM * 2);
  p.bufA = (bf16_t*)take((size_t)TA * DM * 2);
  p.bufB = (bf16_t*)take((size_t)TA * DM * 2);
  p.big = (bf16_t*)take((size_t)TA * 3072 * 2);
  p.hyT = (bf16_t*)take((size_t)3 * 256 * TA * 2);
  p.xs = (bf16_t*)take((size_t)TA * DM * 2);
  p.mod = (float*)take((size_t)DEPTH * MODLAYER * 4);
  p.kfl = (float*)take((size_t)2 * 256 * 8192 * 4);
  p.kfc = (float*)take((size_t)2 * 256 * 512 * 4);
  p.dtb = (float*)take((size_t)TA * 16 * 4);
  p.bar = (unsigned*)take((size_t)XCD_BAR_WORDS * 4);
  if (off > ws_size) { fprintf(stderr, "kernel_launch: workspace too small: need %zu have %zu\n", off, ws_size); return; }
  hipMemsetAsync(p.bar, 0, (size_t)XCD_BAR_WORDS * 4, stream);
#ifndef MK_MULTI
  p.ph_lo = 0; p.ph_hi = NPHASES;
  void* args[] = {&p};
  hipError_t e = hipLaunchCooperativeKernel((const void*)mega, dim3(grid_blocks), dim3(512), args, LDS_TOTAL, stream);
  if (e != hipSuccess) fprintf(stderr, "cooperative launch failed: %s (grid %d)\n", hipGetErrorString(e), grid_blocks);
#else
  for (int ph = 0; ph < NPHASES; ++ph) {
    p.ph_lo = ph; p.ph_hi = ph + 1;
    hipLaunchKernelGGL(mega, dim3(grid_blocks), dim3(512), LDS_TOTAL, stream, p);
  }
#endif
}
```

```cpp
#include <hip/hip_runtime.h>
#include <hip/hip_cooperative_groups.h>
#include <cstdio>
#include <cstring>
namespace cg = cooperative_groups;

typedef unsigned short bf16_t;
typedef short bf16x8 __attribute__((ext_vector_type(8)));
typedef float f32x4 __attribute__((ext_vector_type(4)));
typedef unsigned u32x4 __attribute__((ext_vector_type(4)));
typedef unsigned u32x2 __attribute__((ext_vector_type(2)));
__device__ __forceinline__ u32x4 mk4(unsigned a, unsigned b, unsigned c, unsigned d) { return (u32x4){a, b, c, d}; }
__device__ __forceinline__ u32x4 zero_u4() { unsigned z = 0u; asm volatile("" : "+v"(z)); return (u32x4){z, z, z, z}; }
__device__ __forceinline__ u32x2 mk2(unsigned a, unsigned b) { return (u32x2){a, b}; }

constexpr int NB = 16, SEQ = 4096, DM = 1024, DEPTH = 4, LC = 256;
constexpr int TL = NB * SEQ, TC = NB * LC, TA = TL + TC;
constexpr int DFF = 2816, DIN = 3088;
constexpr int MODROW = 9 * DM;
constexpr int MODLAYER = 17 * MODROW;
constexpr int HALF_LDS = 71680;
constexpr int LDS_BYTES = 2 * HALF_LDS;
constexpr int LDS_TOTAL = LDS_BYTES + 16;
constexpr float EPS = 1e-6f;

struct Params {
  const float *x, *c, *ctx, *c_ctx, *w_mod, *b_mod, *norm_g, *ffn_w_in, *ffn_w_out, *w_in, *w_out;
  const float *hy_conv_w, *hy_conv_b, *fw1, *fb1, *fw2, *fb2, *fw3, *fb3, *fw4, *freq, *hy_bias;
  const float *ssd_conv_w, *ssd_conv_b, *a_log, *dt_bias, *ssd_d, *sc_conv_w, *mix_gain;
  float* out;
  bf16_t *wFin0, *wFin1, *wFout0, *wFout1, *wIn, *wOut;
  bf16_t *bufA, *bufB, *big, *hyT;
  float *mod, *kfl, *kfc, *dtb;
  bf16_t* xs;
  unsigned* bar;
  int ph_lo, ph_hi;
};

#define GLAS __attribute__((address_space(3)))
__device__ __forceinline__ int lane_id() {
  int l; asm volatile("v_mbcnt_lo_u32_b32 %0, -1, 0\n\tv_mbcnt_hi_u32_b32 %0, -1, %0" : "=v"(l)); return l;
}
__device__ __forceinline__ int otid(int wvi) { int t = (wvi & 3) * 64 + lane_id(); asm volatile("" : "+v"(t)); return t; }
__device__ __forceinline__ int obid(int wvi) { int b = __builtin_amdgcn_readfirstlane((int)(blockIdx.x * 2 + (wvi >> 2))); asm volatile("" : "+s"(b)); return b; }
__device__ __forceinline__ int vgrid() { return gridDim.x * 2; }
typedef __bf16 bf16v2_t __attribute__((ext_vector_type(2)));
typedef float f32x2 __attribute__((ext_vector_type(2)));
__device__ __forceinline__ unsigned pk2(float lo, float hi) {
  f32x2 v = {lo, hi};
  bf16v2_t b = __builtin_convertvector(v, bf16v2_t);
  return __builtin_bit_cast(unsigned, b);
}
__device__ __forceinline__ bf16_t f2bf(float f) { return (bf16_t)(pk2(f, 0.f) & 0xffffu); }
__device__ __forceinline__ float bf2f(bf16_t h) { return __uint_as_float(((unsigned)h) << 16); }
__device__ __forceinline__ float lo2f(unsigned u) { return __uint_as_float(u << 16); }
__device__ __forceinline__ float hi2f(unsigned u) { return __uint_as_float(u & 0xffff0000u); }
__device__ __forceinline__ void unpack8(const u32x4& u, float* f) {
  f[0] = lo2f(u.x); f[1] = hi2f(u.x); f[2] = lo2f(u.y); f[3] = hi2f(u.y);
  f[4] = lo2f(u.z); f[5] = hi2f(u.z); f[6] = lo2f(u.w); f[7] = hi2f(u.w);
}
__device__ __forceinline__ u32x4 pack8(const float* f) {
  return mk4(pk2(f[0], f[1]), pk2(f[2], f[3]), pk2(f[4], f[5]), pk2(f[6], f[7]));
}
__device__ __forceinline__ float silu_f(float x) { return x * __builtin_amdgcn_rcpf(1.f + __expf(-x)); }
__device__ __forceinline__ float softplus_f(float x) {
  if (x > 20.f) return x;
  const float e = __expf(x);
  return (e < 0.03f) ? e * (1.f - e * (0.5f - e * (1.f / 3.f - 0.25f * e))) : __logf(1.f + e);
}
__device__ __forceinline__ float wave_sum(float v) {
  const int l4 = lane_id() << 2;
#pragma unroll
  for (int o = 32; o >= 1; o >>= 1) v += __int_as_float(__builtin_amdgcn_ds_bpermute(l4 ^ (o << 2), __float_as_int(v)));
  return v;
}
__device__ __forceinline__ f32x4 zero4() { float z = 0.f; asm volatile("" : "+v"(z)); return (f32x4){z, z, z, z}; }
__device__ __forceinline__ f32x4 mfma16(bf16x8 a, bf16x8 b, f32x4 c) {
  return __builtin_amdgcn_mfma_f32_16x16x32_bf16(a, b, c, 0, 0, 0);
}
__device__ __forceinline__ bf16x8 ldfrag(const bf16_t* p) { return *reinterpret_cast<const bf16x8*>(p); }
__device__ __forceinline__ bf16x8 gather8(const bf16_t* p, int stride) {
  bf16x8 r;
#pragma unroll
  for (int j = 0; j < 8; ++j) r[j] = (short)p[j * stride];
  return r;
}

struct NormCfg {
  const float* src_lat; const float* src_ctx;
  bf16_t* xs;
  float* out32;
  const bf16_t* y; const float* g_post; const float* mod_post; int gate_i; float res_w;
  const float* g_pre; const float* mod_pre; int shift_i; bf16_t* h; int rows;
};

__device__ __forceinline__ void norm_phase(const NormCfg& cf, int wvi) {
  const int tid = otid(wvi); const int lane = tid & 63, w = tid >> 6;
  const int nw = vgrid() * 4, gw = obid(wvi) * 4 + w;
  const int per = (cf.rows + nw - 1) / nw;
  const int wv8 = (gw & 7);
  const int r0 = (gw >> 3) * per * 8 + wv8, r1 = min(cf.rows, (gw >> 3) * per * 8 + per * 8);
  if (r0 >= r1) return;
  const bool has_post = cf.y != nullptr, has_pre = cf.h != nullptr;
  const bool src32 = cf.src_lat != nullptr;
  auto ld8 = [&](const float* base, int i, float* d) {
    const float4 a = reinterpret_cast<const float4*>(base)[2 * (lane + 64 * i)];
    const float4 c = reinterpret_cast<const float4*>(base)[2 * (lane + 64 * i) + 1];
    d[0] = a.x; d[1] = a.y; d[2] = a.z; d[3] = a.w; d[4] = c.x; d[5] = c.y; d[6] = c.z; d[7] = c.w;
  };
  float gpo[2][8], gpr[2][8], gate[2][8], sh[2][8], sc[2][8];
#pragma unroll
  for (int i = 0; i < 2; ++i) {
#pragma unroll
    for (int k = 0; k < 8; ++k) { gpo[i][k] = 0.f; gpr[i][k] = 0.f; gate[i][k] = 0.f; sh[i][k] = 0.f; sc[i][k] = 0.f; }
    if (has_post) ld8(cf.g_post, i, gpo[i]);
    if (has_pre) ld8(cf.g_pre, i, gpr[i]);
  }
  int cur_m = -1;
  struct RowRegs { float4 xn[2][2]; u32x4 xb[2], yn[2]; };
  RowRegs Q0, Q1;
  auto fetch = [&](int row, RowRegs& Q) {
    if (src32) {
      const float* src = (row < TL) ? cf.src_lat + (size_t)row * DM : cf.src_ctx + (size_t)(row - TL) * DM;
#pragma unroll
      for (int i = 0; i < 2; ++i) {
        Q.xn[i][0] = reinterpret_cast<const float4*>(src)[2 * (lane + 64 * i)];
        Q.xn[i][1] = reinterpret_cast<const float4*>(src)[2 * (lane + 64 * i) + 1];
      }
    } else {
      const u32x4* xp = reinterpret_cast<const u32x4*>(cf.xs + (size_t)row * DM);
#pragma unroll
      for (int i = 0; i < 2; ++i) Q.xb[i] = xp[lane + 64 * i];
    }
    if (has_post) {
      const u32x4* yp = reinterpret_cast<const u32x4*>(cf.y + (size_t)row * DM);
#pragma unroll
      for (int i = 0; i < 2; ++i) Q.yn[i] = yp[lane + 64 * i];
    }
  };
  fetch(r0, Q0);
  if (r0 + 8 < r1) fetch(r0 + 8, Q1);
  for (int row = r0; row < r1; row += 8) {
    float xv[2][8], yv[2][8];
#pragma unroll
    for (int i = 0; i < 2; ++i) {
      if (src32) {
        xv[i][0] = Q0.xn[i][0].x; xv[i][1] = Q0.xn[i][0].y; xv[i][2] = Q0.xn[i][0].z; xv[i][3] = Q0.xn[i][0].w;
        xv[i][4] = Q0.xn[i][1].x; xv[i][5] = Q0.xn[i][1].y; xv[i][6] = Q0.xn[i][1].z; xv[i][7] = Q0.xn[i][1].w;
      } else unpack8(Q0.xb[i], xv[i]);
      unpack8(Q0.yn[i], yv[i]);
    }
    Q0 = Q1;
    if (row + 16 < r1) fetch(row + 16, Q1);
    const int mrow = (row < TL) ? (row >> 12) : 16;
    if (mrow != cur_m) {
      cur_m = mrow;
#pragma unroll
      for (int i = 0; i < 2; ++i) {
        if (has_post) ld8(cf.mod_post + (size_t)mrow * MODROW + cf.gate_i * DM, i, gate[i]);
        if (has_pre) {
          ld8(cf.mod_pre + (size_t)mrow * MODROW + cf.shift_i * DM, i, sh[i]);
          ld8(cf.mod_pre + (size_t)mrow * MODROW + (cf.shift_i + 1) * DM, i, sc[i]);
        }
      }
    }
    if (has_post) {
      float ss = 0.f;
#pragma unroll
      for (int i = 0; i < 2; ++i)
#pragma unroll
        for (int k = 0; k < 8; ++k) ss += yv[i][k] * yv[i][k];
      ss = wave_sum(ss);
      const float rstd = rsqrtf(ss * (1.f / DM) + EPS) * cf.res_w;
#pragma unroll
      for (int i = 0; i < 2; ++i)
#pragma unroll
        for (int k = 0; k < 8; ++k) xv[i][k] += gate[i][k] * gpo[i][k] * yv[i][k] * rstd;
      if (cf.out32) {
        float4* op = reinterpret_cast<float4*>(cf.out32 + (size_t)row * DM);
#pragma unroll
        for (int i = 0; i < 2; ++i) {
          op[2 * (lane + 64 * i)] = make_float4(xv[i][0], xv[i][1], xv[i][2], xv[i][3]);
          op[2 * (lane + 64 * i) + 1] = make_float4(xv[i][4], xv[i][5], xv[i][6], xv[i][7]);
        }
      } else {
        u32x4* xp = reinterpret_cast<u32x4*>(cf.xs + (size_t)row * DM);
#pragma unroll
        for (int i = 0; i < 2; ++i) {
          const u32x4 pk = pack8(xv[i]);
          xp[lane + 64 * i] = pk;
          unpack8(pk, xv[i]);
        }
      }
    }
    if (has_pre) {
      float ss = 0.f;
#pragma unroll
      for (int i = 0; i < 2; ++i)
#pragma unroll
        for (int k = 0; k < 8; ++k) ss += xv[i][k] * xv[i][k];
      ss = wave_sum(ss);
      const float rstd = rsqrtf(ss * (1.f / DM) + EPS);
      u32x4* hp = reinterpret_cast<u32x4*>(cf.h + (size_t)row * DM);
#pragma unroll
      for (int i = 0; i < 2; ++i) {
        float hv[8];
#pragma unroll
        for (int k = 0; k < 8; ++k) hv[k] = xv[i][k] * rstd * gpr[i][k] * (1.f + sc[i][k]) + sh[i][k];
        hp[lane + 64 * i] = pack8(hv);
      }
    }
  }
}

enum { EPI_PLAIN = 0, EPI_SWIGLU = 1, EPI_INPROJ = 2 };
constexpr int GBM = 256, GBK = 64, GHALF = 128, GHT = GHALF * GBK, GNXCD = 8, GWGM = 8;

__device__ __forceinline__ int lds_byte(int r, int c) {
  const int st = (r >> 4) * 2 + (c >> 5), rr = r & 15, cc = c & 31, ob = rr * 64 + cc * 2;
  return st * 1024 + (ob ^ (((ob >> 9) & 1) << 5));
}
__device__ __forceinline__ void stage_rc(int b, int& R, int& C) {
  const int st = b / 1024, sb = b % 1024, swz = sb ^ (((sb >> 9) & 1) << 5);
  R = (st >> 1) * 16 + swz / 64; C = (st & 1) * 32 + (swz % 64) / 2;
}

__device__ __forceinline__ void gemm_phase(const Params& p, int l, const bf16_t* __restrict__ A, const bf16_t* __restrict__ Bt, int M, int N, int K,
                           int epi, bf16_t* __restrict__ outp, char* smem, int wvi) {
  GLAS unsigned char* lds = (GLAS unsigned char*)smem;
  const int wid = wvi; int tidx = wvi * 64 + lane_id(); asm volatile("" : "+v"(tidx));
  const int lane = tidx & 63, wr = wid >> 2, wc = wid & 3, fr = lane & 15, fq = lane >> 4;
  const int nt = K / GBK;
  unsigned voff[2];
#pragma unroll
  for (int i = 0; i < 2; ++i) { int R, C; stage_rc(tidx * 16 + i * 8192, R, C); voff[i] = (unsigned)(R * K + C) * 2u; }
  const size_t kstep = (size_t)(GBK * 2), hstep = (size_t)GHALF * K * 2, tstep = 2 * hstep;
  const unsigned ldsw = (unsigned)wid * 1024u;
  const int aoff = lds_byte(wr * 64 + fr, fq * 8), boff = lds_byte(wc * 32 + fr, fq * 8);
  constexpr int HTB = GHT * 2;
#define G_SA(b, h) (((b) * 2 + (h)) * HTB)
#define G_SB(b, h) ((4 + (b) * 2 + (h)) * HTB)
#define G_STAGE(bufoff, gbase) do { _Pragma("unroll") for (int _i = 0; _i < 2; ++_i) \
    __builtin_amdgcn_global_load_lds((const unsigned*)((const char*)(gbase) + voff[_i]), (GLAS unsigned*)(lds + (bufoff) + ldsw + _i * 8192), 16, 0, 0); } while (0)
#define G_LDA(dst, b, h) do { _Pragma("unroll") for (int m = 0; m < 4; ++m) _Pragma("unroll") for (int k = 0; k < 2; ++k) \
    dst[m][k] = *(const GLAS bf16x8*)(lds + G_SA(b, h) + aoff + m * 2048 + k * 1024); } while (0)
#define G_LDB(dst, b, h) do { _Pragma("unroll") for (int n = 0; n < 2; ++n) _Pragma("unroll") for (int k = 0; k < 2; ++k) \
    dst[n][k] = *(const GLAS bf16x8*)(lds + G_SB(b, h) + boff + n * 2048 + k * 1024); } while (0)
#define G_MMA(ai, bj, At_, Bt_) do { __builtin_amdgcn_s_setprio(1); \
    _Pragma("unroll") for (int m = 0; m < 4; ++m) _Pragma("unroll") for (int n = 0; n < 2; ++n) _Pragma("unroll") for (int k = 0; k < 2; ++k) \
      acc[ai][bj][m][n] = __builtin_amdgcn_mfma_f32_16x16x32_bf16(Bt_[n][k], At_[m][k], acc[ai][bj][m][n], 0, 0, 0); \
    __builtin_amdgcn_s_setprio(0); } while (0)
#define G_WAIT_V(n) asm volatile("s_waitcnt vmcnt(" #n ")" ::: "memory")
#define G_WAIT_L(n) asm volatile("s_waitcnt lgkmcnt(" #n ")" ::: "memory")
#define G_BAR __builtin_amdgcn_s_barrier()
#define G_SCHED __builtin_amdgcn_sched_barrier(0)
  const int nM = M / GBM, nN = N / GBM, nwg = nM * nN;
  auto tile_of = [&](int Lw, int& pm_, int& pn_) {
    int wgid = Lw;
    { const int q = nwg / GNXCD, r = nwg % GNXCD, xcd = wgid % GNXCD, off = wgid / GNXCD; wgid = (xcd < r ? xcd * (q + 1) : r * (q + 1) + (xcd - r) * q) + off; }
    const int nig = GWGM * nN, gid = wgid / nig, fm = gid * GWGM, gsz = min(nM - fm, GWGM);
    pm_ = fm + ((wgid % nig) % gsz); pn_ = (wgid % nig) / gsz;
  };
  int Lw = blockIdx.x;
  if (Lw < nwg) {
    int pm, pn; tile_of(Lw, pm, pn);
    const char* cA = (const char*)A + (size_t)pm * tstep;
    const char* cB = (const char*)Bt + (size_t)pn * tstep;
    f32x4 acc[2][2][4][2];
#pragma unroll
    for (int a = 0; a < 2; ++a)
#pragma unroll
      for (int b = 0; b < 2; ++b)
#pragma unroll
        for (int m = 0; m < 4; ++m)
#pragma unroll
          for (int n = 0; n < 2; ++n) acc[a][b][m][n] = zero4();
    bf16x8 At[4][2], B0[2][2], B1[2][2];
    G_STAGE(G_SB(0, 0), cB); G_STAGE(G_SA(0, 0), cA); G_STAGE(G_SB(0, 1), cB + hstep); G_STAGE(G_SA(0, 1), cA + hstep);
    if (wr == 1) G_BAR;
    G_WAIT_V(4); G_BAR;
    G_STAGE(G_SB(1, 0), cB + kstep); G_STAGE(G_SA(1, 0), cA + kstep); G_STAGE(G_SB(1, 1), cB + hstep + kstep);
    G_WAIT_V(6); G_BAR;
    for (;;) {
      const int Ln = Lw + gridDim.x;
      const bool has_next = Ln < nwg;
      int npm = pm, npn = pn;
      if (has_next) tile_of(Ln, npm, npn);
      const char* nA = (const char*)A + (size_t)npm * tstep; const char* nB = (const char*)Bt + (size_t)npn * tstep;
      for (int t = 0; t < nt; t += 2) {
        const bool lastt = (t == nt - 2);
        const char* a1 = cA + (size_t)(t + 1) * kstep;
        const char* a2 = lastt ? nA : cA + (size_t)(t + 2) * kstep; const char* b2 = lastt ? nB : cB + (size_t)(t + 2) * kstep;
        const char* a3 = a2 + kstep; const char* b3 = b2 + kstep;
        G_LDB(B0, 0, 0); G_SCHED; G_LDA(At, 0, 0); G_STAGE(G_SA(1, 1), a1 + hstep);
        G_WAIT_L(8); G_BAR; G_WAIT_L(0); G_MMA(0, 0, At, B0); G_BAR; G_SCHED;
        G_LDB(B1, 0, 1); G_STAGE(G_SB(0, 0), b2);
        G_BAR; G_WAIT_L(0); G_MMA(0, 1, At, B1); G_BAR;
        G_LDA(At, 0, 1); G_STAGE(G_SA(0, 0), a2);
        G_BAR; G_WAIT_L(0); G_MMA(1, 0, At, B0); G_BAR; G_SCHED;
        G_STAGE(G_SB(0, 1), b2 + hstep);
        G_WAIT_V(6); G_BAR; G_MMA(1, 1, At, B1); G_BAR;
        G_LDB(B0, 1, 0); G_SCHED; G_LDA(At, 1, 0); G_STAGE(G_SA(0, 1), a2 + hstep);
        G_WAIT_L(8); G_BAR; G_WAIT_L(0); G_MMA(0, 0, At, B0); G_BAR; G_SCHED;
        G_LDB(B1, 1, 1); G_STAGE(G_SB(1, 0), b3);
        G_BAR; G_WAIT_L(0); G_MMA(0, 1, At, B1); G_BAR;
        G_LDA(At, 1, 1); G_STAGE(G_SA(1, 0), a3);
        G_BAR; G_WAIT_L(0); G_MMA(1, 0, At, B0); G_BAR; G_SCHED;
        G_STAGE(G_SB(1, 1), b3 + hstep);
        G_WAIT_V(6); G_BAR; G_MMA(1, 1, At, B1); G_BAR;
      }
      const int brow = pm * GBM, bcol = pn * GBM;
    const int r0 = brow + wr * 64 + fr;
    if (epi == EPI_PLAIN) {
#pragma unroll
      for (int ai = 0; ai < 2; ++ai)
#pragma unroll
        for (int m = 0; m < 4; ++m) {
          bf16_t* rp = outp + (size_t)(r0 + ai * GHALF + m * 16) * N + bcol + wc * 32 + fq * 8;
#pragma unroll
          for (int bj = 0; bj < 2; ++bj) {
            const f32x4 v0 = acc[ai][bj][m][0], v1 = acc[ai][bj][m][1];
            *reinterpret_cast<u32x4*>(rp + bj * GHALF) = mk4(pk2(v0[0], v0[1]), pk2(v0[2], v0[3]), pk2(v1[0], v1[1]), pk2(v1[2], v1[3]));
          }
        }
    } else if (epi == EPI_SWIGLU) {
#pragma unroll
      for (int ai = 0; ai < 2; ++ai)
#pragma unroll
        for (int m = 0; m < 4; ++m) {
          bf16_t* rp = outp + (size_t)(r0 + ai * GHALF + m * 16) * DFF + pn * 128 + wc * 32 + fq * 8;
          unsigned pk[4];
#pragma unroll
          for (int bj = 0; bj < 2; ++bj) {
            const f32x4 g = acc[ai][bj][m][0], u = acc[ai][bj][m][1];
            const float o0 = silu_f(g[0]) * u[0], o1 = silu_f(g[1]) * u[1], o2 = silu_f(g[2]) * u[2], o3 = silu_f(g[3]) * u[3];
            pk[2 * bj] = pk2(o0, o1); pk[2 * bj + 1] = pk2(o2, o3);
          }
          *reinterpret_cast<u32x4*>(rp) = mk4(pk[0], pk[1], pk[2], pk[3]);
        }
    } else {
      if (pn < 12) {
        bf16_t* dst; int ld, c0;
        if (pn < 3) { dst = p.big; ld = 768; c0 = pn * 256; }
        else if (pn < 5) { dst = p.big + (size_t)TA * 768; ld = 512; c0 = (pn - 3) * 256; }
        else if (pn < 9) { dst = p.big + (size_t)TA * 1280; ld = 1024; c0 = (pn - 5) * 256; }
        else { dst = p.big + (size_t)TA * 2304; ld = 768; c0 = (pn - 9) * 256; }
#pragma unroll
        for (int ai = 0; ai < 2; ++ai)
#pragma unroll
          for (int m = 0; m < 4; ++m) {
            bf16_t* rp = dst + (size_t)(r0 + ai * GHALF + m * 16) * ld + c0 + wc * 32 + fq * 8;
#pragma unroll
            for (int bj = 0; bj < 2; ++bj) {
              const f32x4 v0 = acc[ai][bj][m][0], v1 = acc[ai][bj][m][1];
              *reinterpret_cast<u32x4*>(rp + bj * GHALF) = mk4(pk2(v0[0], v0[1]), pk2(v0[2], v0[3]), pk2(v1[0], v1[1]), pk2(v1[2], v1[3]));
            }
          }
      } else if (wc == 0 && fq < 2) {
        const float* db = p.dt_bias + l * 16 + fq * 8;
        float dbv[8];
#pragma unroll
        for (int i = 0; i < 8; ++i) dbv[i] = db[i];
#pragma unroll
        for (int ai = 0; ai < 2; ++ai)
#pragma unroll
          for (int m = 0; m < 4; ++m) {
            const f32x4 v0 = acc[ai][0][m][0], v1 = acc[ai][0][m][1];
            float4 o0, o1;
            o0.x = softplus_f(v0[0] + dbv[0]); o0.y = softplus_f(v0[1] + dbv[1]); o0.z = softplus_f(v0[2] + dbv[2]); o0.w = softplus_f(v0[3] + dbv[3]);
            o1.x = softplus_f(v1[0] + dbv[4]); o1.y = softplus_f(v1[1] + dbv[5]); o1.z = softplus_f(v1[2] + dbv[6]); o1.w = softplus_f(v1[3] + dbv[7]);
            float* dp = p.dtb + (size_t)(r0 + ai * GHALF + m * 16) * 16 + fq * 8;
            *reinterpret_cast<float4*>(dp) = o0;
            *reinterpret_cast<float4*>(dp + 4) = o1;
          }
      }
    }
      if (!has_next) break;
#pragma unroll
      for (int a = 0; a < 2; ++a)
#pragma unroll
        for (int b = 0; b < 2; ++b)
#pragma unroll
          for (int m = 0; m < 4; ++m)
#pragma unroll
            for (int n = 0; n < 2; ++n) acc[a][b][m][n] = zero4();
      Lw = Ln; pm = npm; pn = npn; cA = nA; cB = nB;
    }
    G_WAIT_V(0);
    if (wr == 0) G_BAR;
    G_BAR;
  }
  __syncthreads();
#undef G_SA
#undef G_SB
#undef G_STAGE
#undef G_LDA
#undef G_LDB
#undef G_MMA
#undef G_WAIT_V
#undef G_WAIT_L
#undef G_BAR
#undef G_SCHED
}

__device__ __forceinline__ void prep_filter_item(const Params& p, int l, int it, char* smem, int wvi) {
  const int tid = otid(wvi);
  int pos0, L;
  if (it < 256) { pos0 = it * 16; L = SEQ; } else { pos0 = (it - 256) * 16; L = LC; }
  const float inv_lm1 = (L == SEQ) ? (1.f / (float)(SEQ - 1)) : (1.f / (float)(LC - 1));
  const double inv_l = (L == SEQ) ? (1.0 / (double)SEQ) : (1.0 / (double)LC);
  float* sF = reinterpret_cast<float*>(smem);
  float* sH1 = sF + 16 * 33;
  float* sH2 = sH1 + 16 * 64;
  float* sH3 = sH2 + 16 * 64;
  __syncthreads();
  for (int idx = tid; idx < 16 * 33; idx += 256) {
    const int ps = idx / 33, k = idx - ps * 33;
    const int i = pos0 + ps;
    float v;
    if (k == 0) v = (float)i * inv_lm1;
    else {
      const int j = (k - 1) & 15;
      const double f = 1e-4 + (double)j * ((15.0 - 1e-4) / 15.0);
      double r = f * (double)i * inv_l;
      r -= floor(r);
      const float ang = 6.283185307179586f * (float)r;
      v = (k <= 16) ? cosf(ang) : -sinf(ang);
    }
    sF[idx] = v;
  }
  __syncthreads();
  const int u = tid & 63, pg = tid >> 6;
  const float fr = p.freq[l * 64 + u];
  {
    const float* W = p.fw1 + (size_t)l * 33 * 64; const float bb = p.fb1[l * 64 + u];
#pragma unroll 1
    for (int q = 0; q < 4; ++q) {
      const int ps = pg * 4 + q; float a = bb;
      for (int k = 0; k < 33; ++k) a += sF[ps * 33 + k] * W[k * 64 + u];
      sH1[ps * 64 + u] = sinf(fr * a);
    }
  }
  __syncthreads();
  {
    const float* W = p.fw2 + (size_t)l * 64 * 64; const float bb = p.fb2[l * 64 + u];
#pragma unroll 1
    for (int q = 0; q < 4; ++q) {
      const int ps = pg * 4 + q; float a = bb;
      for (int k = 0; k < 64; ++k) a += sH1[ps * 64 + k] * W[k * 64 + u];
      sH2[ps * 64 + u] = sinf(fr * a);
    }
  }
  __syncthreads();
  {
    const float* W = p.fw3 + (size_t)l * 64 * 64; const float bb = p.fb3[l * 64 + u];
#pragma unroll 1
    for (int q = 0; q < 4; ++q) {
      const int ps = pg * 4 + q; float a = bb;
      for (int k = 0; k < 64; ++k) a += sH2[ps * 64 + k] * W[k * 64 + u];
      sH3[ps * 64 + u] = sinf(fr * a);
    }
  }
  __syncthreads();
  const float* W4 = p.fw4 + (size_t)l * 64 * 1024;
  const float a0 = -3.0701134573253944f, a1 = -15.350567286626972f;
  for (int cc = 0; cc < 4; ++cc) {
    const int col = tid + 256 * cc;
    const int o = col >> 9, dr = (col >> 8) & 1, ch = col & 255;
    const float dl = fabsf(a0 + (float)ch * ((a1 - a0) / 255.f));
    for (int half = 0; half < 2; ++half) {
      float acc[8];
#pragma unroll
      for (int q = 0; q < 8; ++q) acc[q] = 0.f;
      for (int k = 0; k < 64; ++k) {
        const float wv = W4[k * 1024 + col];
#pragma unroll
        for (int q = 0; q < 8; ++q) acc[q] += sH3[(half * 8 + q) * 64 + k] * wv;
      }
#pragma unroll
      for (int q = 0; q < 8; ++q) {
        const int i = pos0 + half * 8 + q;
        const float t = (float)i * inv_lm1;
        const float v = acc[q] * expf(-t * dl);
        float* kb = (L == SEQ) ? p.kfl + (size_t)(o * 256 + ch) * 8192 : p.kfc + (size_t)(o * 256 + ch) * 512;
        const int mid = (L == SEQ) ? 4096 : 256;
        const int idx = (dr == 0) ? mid + i : ((i >= 1) ? mid - i : 0);
        kb[idx] = v;
      }
    }
  }
}

__device__ __forceinline__ void prep_mod_item(const Params& p, int it, char* smem, int wvi) {
  const int tid = otid(wvi), lane = tid & 63, w = tid >> 6;
  const int l2 = it / 144, col0 = (it - l2 * 144) * 64;
  float* sS = reinterpret_cast<float*>(smem);
  float* sR = sS + 17 * 256;
  float acc[17];
#pragma unroll
  for (int m = 0; m < 17; ++m) acc[m] = 0.f;
  for (int kc = 0; kc < 4; ++kc) {
    __syncthreads();
    for (int idx = tid; idx < 17 * 256; idx += 256) {
      const int m = idx >> 8, k = idx & 255;
      const float v = (m < 16) ? p.c[m * DM + kc * 256 + k] : p.c_ctx[kc * 256 + k];
      sS[idx] = v * __builtin_amdgcn_rcpf(1.f + expf(-v));
    }
    __syncthreads();
    const float* Wp = p.w_mod + ((size_t)l2 * DM + kc * 256 + w * 64) * MODROW + col0 + lane;
    for (int kk = 0; kk < 64; ++kk) {
      const float wv = Wp[(size_t)kk * MODROW];
      const float* sp = sS + w * 64 + kk;
#pragma unroll
      for (int m = 0; m < 17; ++m) acc[m] += sp[m * 256] * wv;
    }
  }
  __syncthreads();
#pragma unroll
  for (int m = 0; m < 17; ++m) sR[(w * 17 + m) * 64 + lane] = acc[m];
  __syncthreads();
  for (int idx = tid; idx < 17 * 64; idx += 256) {
    const int m = idx >> 6, cl = idx & 63;
    float s = p.b_mod[l2 * MODROW + col0 + cl];
#pragma unroll
    for (int ww = 0; ww < 4; ++ww) s += sR[(ww * 17 + m) * 64 + cl];
    p.mod[(size_t)(l2 * 17 + m) * MODROW + col0 + cl] = s;
  }
}

__device__ __forceinline__ int perm32(int rho) { const int n = rho >> 4, i = rho & 15; return 8 * (i >> 2) + 4 * n + (i & 3); }
__device__ __forceinline__ int srccol(int mode, int n) {
  if (mode == 0) return (n & ~31) + perm32(n & 31);
  if (mode == 1) {
    const int tile = n >> 8, r = n & 255, bj = r >> 7, wc = (r >> 5) & 3, q = (r >> 4) & 1, i = r & 15;
    return (q ? DFF : 0) + tile * 128 + wc * 32 + (i >> 2) * 8 + bj * 4 + (i & 3);
  }
  const int L = (n & ~31) + perm32(n & 31);
  if (L < 2304) return L;
  if (L < 3072) return L + 16;
  if (L < 3088) return L - 768;
  return -1;
}

__device__ __forceinline__ void prep_conv_item(const Params& p, int l, int it, char* smem, int wvi) {
  const int tid = otid(wvi);
  const float* src; bf16_t* dst; int ld, K, mode, KT;
  if (it < 2816) { const int i = it / 1408; it -= i * 1408; src = p.ffn_w_in + (size_t)(l * 2 + i) * DM * 2 * DFF; dst = i ? p.wFin1 : p.wFin0; ld = 2 * DFF; K = DM; mode = 1; KT = 16; }
  else if (it < 4224) { it -= 2816; const int i = it / 704; it -= i * 704; src = p.ffn_w_out + (size_t)(l * 2 + i) * DFF * DM; dst = i ? p.wFout1 : p.wFout0; ld = DM; K = DFF; mode = 0; KT = 44; }
  else if (it < 5056) { it -= 4224; src = p.w_in + (size_t)l * DM * DIN; dst = p.wIn; ld = DIN; K = DM; mode = 2; KT = 16; }
  else { it -= 5056; src = p.w_out + (size_t)l * DM * DM; dst = p.wOut; ld = DM; K = DM; mode = 0; KT = 16; }
  const int ntile = it / KT, ktile = it - ntile * KT;
  const int n0 = ntile * 64, k0 = ktile * 64;
  float* sT = reinterpret_cast<float*>(smem);
  __syncthreads();
#pragma unroll 4
  for (int i = 0; i < 16; ++i) {
    const int idx = tid + 256 * i, k = idx >> 6, n = idx & 63;
    const int sc = srccol(mode, n0 + n);
    sT[k * 65 + n] = (sc >= 0) ? src[(size_t)(k0 + k) * ld + sc] : 0.f;
  }
  __syncthreads();
#pragma unroll
  for (int i = 0; i < 2; ++i) {
    const int idx = tid + 256 * i, n = idx >> 3, kg = idx & 7;
    float f[8];
#pragma unroll
    for (int j = 0; j < 8; ++j) f[j] = sT[(kg * 8 + j) * 65 + n];
    *reinterpret_cast<u32x4*>(dst + (size_t)(n0 + n) * K + k0 + kg * 8) = pack8(f);
  }
}

__device__ __forceinline__ void prep_phase(const Params& p, int l, char* smem, int wvi, int part) {
  const int nfilt = 272, nmod = (l == 0) ? 576 : 0;
  constexpr int FOUT1_LO = 3520, FOUT1_N = 704, NCONV = 5312;
  if (part == 0) {
    const int total = nfilt + nmod + NCONV;
    for (int it = obid(wvi); it < total; it += vgrid()) {
      if (it < nfilt) prep_filter_item(p, l, it, smem, wvi);
      else if (it < nfilt + nmod) prep_mod_item(p, it - nfilt, smem, wvi);
      else prep_conv_item(p, l, it - nfilt - nmod, smem, wvi);
    }
  } else if (part == 1) {
    const int total = nfilt + NCONV - FOUT1_N;
    for (int j = obid(wvi) - 128; j < total; j += vgrid() - 128) {
      if (j < nfilt) prep_filter_item(p, l, j, smem, wvi);
      else { const int c = j - nfilt; prep_conv_item(p, l, c < FOUT1_LO ? c : c + FOUT1_N, smem, wvi); }
    }
  } else {
    for (int j = obid(wvi); j < FOUT1_N; j += vgrid()) prep_conv_item(p, l, FOUT1_LO + j, smem, wvi);
  }
}

__device__ __forceinline__ void conv_ssd_item(const Params& p, int l, int item, int wvi) {
  const int sg = item >> 2, cc = item & 3;
  const int tid = otid(wvi), cg8 = tid & 31, pc = tid >> 5;
  const int col = cc * 256 + cg8 * 8;
  int segbase, PL;
  if (sg < 1024) { segbase = sg * 64; PL = 8; } else { segbase = TL + (sg - 1024) * 256; PL = 32; }
  bf16_t* base = p.big + (size_t)TA * 1280 + (size_t)segbase * 1024 + col;
  float w0[8], w1[8], w2[8], bb[8];
  {
    const float* cw = p.ssd_conv_w + (size_t)l * 3 * 1024 + col;
    const float* cb = p.ssd_conv_b + (size_t)l * 1024 + col;
#pragma unroll
    for (int i = 0; i < 8; ++i) { w0[i] = cw[i]; w1[i] = cw[1024 + i]; w2[i] = cw[2048 + i]; bb[i] = cb[i]; }
  }
  const int r0 = pc * PL;
  const u32x4 zero = zero_u4();
  const u32x4 hprev = (pc > 0) ? *reinterpret_cast<const u32x4*>(base + (size_t)(r0 - 1) * 1024) : zero;
  const u32x4 hnext = (pc < 7) ? *reinterpret_cast<const u32x4*>(base + (size_t)(r0 + PL) * 1024) : zero;
  const u32x4 cur0 = *reinterpret_cast<const u32x4*>(base + (size_t)r0 * 1024);
  __syncthreads();
  float fp[8], fc[8], fn[8];
  unpack8(hprev, fp); unpack8(cur0, fc);
  for (int k = 0; k < PL; k += 8) {
    u32x4 rows[8];
#pragma unroll
    for (int j = 0; j < 8; ++j)
      rows[j] = (k + j + 1 < PL) ? *reinterpret_cast<const u32x4*>(base + (size_t)(r0 + k + j + 1) * 1024) : hnext;
#pragma unroll
    for (int j = 0; j < 8; ++j) {
      unpack8(rows[j], fn);
      float o[8];
#pragma unroll
      for (int i = 0; i < 8; ++i) o[i] = silu_f(w0[i] * fp[i] + w1[i] * fc[i] + w2[i] * fn[i] + bb[i]);
      *reinterpret_cast<u32x4*>(base + (size_t)(r0 + k + j) * 1024) = pack8(o);
#pragma unroll
      for (int i = 0; i < 8; ++i) { fp[i] = fc[i]; fc[i] = fn[i]; }
    }
  }
}

__device__ __forceinline__ void conv_hy_item(const Params& p, int l, int item, char* smem, int wvi) {
  const int tid = otid(wvi);
  const int pi = item / 3, part = item - pi * 3;
  int tok0; bool hasPrev = false, hasNext = false;
  if (pi < 1024) tok0 = pi * 64;
  else { const int j = pi - 1024, qq = j & 3; tok0 = TL + (j >> 2) * 256 + qq * 64; hasPrev = qq > 0; hasNext = qq < 3; }
  bf16_t* sIn = reinterpret_cast<bf16_t*>(smem);
  bf16_t* sOut = sIn + 66 * 264;
  const bf16_t* ph = p.big + part * 256;
  __syncthreads();
  for (int slot = tid; slot < 66 * 32; slot += 256) {
    const int r = slot >> 5, c8 = slot & 31;
    const bool valid = (r == 0) ? hasPrev : ((r == 65) ? hasNext : true);
    u32x4 v = zero_u4();
    if (valid) v = *reinterpret_cast<const u32x4*>(ph + (size_t)(tok0 - 1 + r) * 768 + c8 * 8);
    *reinterpret_cast<u32x4*>(sIn + r * 264 + c8 * 8) = v;
  }
  __syncthreads();
  {
    const int c = tid, ch = part * 256 + c;
    const float* cw = p.hy_conv_w + (size_t)l * 3 * 768 + ch;
    const float w0 = cw[0], w1 = cw[768], w2 = cw[1536], bb = p.hy_conv_b[l * 768 + ch];
    float a = bf2f(sIn[c]), b = bf2f(sIn[264 + c]);
#pragma unroll 8
    for (int t = 0; t < 64; ++t) {
      const float cn = bf2f(sIn[(t + 2) * 264 + c]);
      sOut[c * 66 + t] = f2bf(w0 * a + w1 * b + w2 * cn + bb);
      a = b; b = cn;
    }
  }
  __syncthreads();
#pragma unroll
  for (int i = 0; i < 4; ++i) {
    const int slot = tid + 256 * i, c = slot >> 2, q4 = slot & 3;
    const unsigned* sp = reinterpret_cast<const unsigned*>(sOut + c * 66 + q4 * 16);
    u32x4 v0 = mk4(sp[0], sp[1], sp[2], sp[3]), v1 = mk4(sp[4], sp[5], sp[6], sp[7]);
    bf16_t* dp = p.hyT + (size_t)(part * 256 + c) * TA + tok0 + q4 * 16;
    *reinterpret_cast<u32x4*>(dp) = v0;
    *reinterpret_cast<u32x4*>(dp + 8) = v1;
  }
}

__device__ __forceinline__ void shortconv_tokens(const Params& p, int l, int wvi) {
  const int tid = otid(wvi); const int lane = tid & 63, w = tid >> 6;
  const int nw = vgrid() * 4;
  const bf16_t* ps = p.big + (size_t)TA * 2304;
  const int ch = lane * 4;
  float w0[4], w1[4], w2[4], gn[4];
#pragma unroll
  for (int i = 0; i < 4; ++i) {
    w0[i] = p.sc_conv_w[l * 768 + ch + i]; w1[i] = p.sc_conv_w[l * 768 + 256 + ch + i]; w2[i] = p.sc_conv_w[l * 768 + 512 + ch + i];
    gn[i] = p.mix_gain[l * 1024 + 768 + ch + i];
  }
  const int per = (TA + nw - 1) / nw, gw = obid(wvi) * 4 + w;
  const int r0 = gw * per, r1 = min(TA, r0 + per);
  if (r0 >= r1) return;
  const u32x2 z2 = mk2(0u, 0u);
  u32x2 gcp = z2, hxp = z2, gcc, hxc, gbc, gcn = z2, hxn = z2, gbn = z2;
  if (r0 > 0) { gcp = *reinterpret_cast<const u32x2*>(ps + (size_t)(r0 - 1) * 768 + 256 + ch); hxp = *reinterpret_cast<const u32x2*>(ps + (size_t)(r0 - 1) * 768 + 512 + ch); }
  gbc = *reinterpret_cast<const u32x2*>(ps + (size_t)r0 * 768 + ch);
  gcc = *reinterpret_cast<const u32x2*>(ps + (size_t)r0 * 768 + 256 + ch);
  hxc = *reinterpret_cast<const u32x2*>(ps + (size_t)r0 * 768 + 512 + ch);
  for (int tok = r0; tok < r1; ++tok) {
    if (tok + 1 < TA) {
      const bf16_t* np = ps + (size_t)(tok + 1) * 768 + ch;
      gbn = *reinterpret_cast<const u32x2*>(np); gcn = *reinterpret_cast<const u32x2*>(np + 256); hxn = *reinterpret_cast<const u32x2*>(np + 512);
    }
    int ps_, sl;
    if (tok < TL) { ps_ = tok & 63; sl = 64; } else { ps_ = (tok - TL) & 255; sl = 256; }
    const float mp = (ps_ > 0) ? 1.f : 0.f, mn = (ps_ < sl - 1) ? 1.f : 0.f;
    float v[4];
    v[0] = lo2f(gbc.x) * (mp * w0[0] * lo2f(gcp.x) * lo2f(hxp.x) + w1[0] * lo2f(gcc.x) * lo2f(hxc.x) + mn * w2[0] * lo2f(gcn.x) * lo2f(hxn.x));
    v[1] = hi2f(gbc.x) * (mp * w0[1] * hi2f(gcp.x) * hi2f(hxp.x) + w1[1] * hi2f(gcc.x) * hi2f(hxc.x) + mn * w2[1] * hi2f(gcn.x) * hi2f(hxn.x));
    v[2] = lo2f(gbc.y) * (mp * w0[2] * lo2f(gcp.y) * lo2f(hxp.y) + w1[2] * lo2f(gcc.y) * lo2f(hxc.y) + mn * w2[2] * lo2f(gcn.y) * lo2f(hxn.y));
    v[3] = hi2f(gbc.y) * (mp * w0[3] * hi2f(gcp.y) * hi2f(hxp.y) + w1[3] * hi2f(gcc.y) * hi2f(hxc.y) + mn * w2[3] * hi2f(gcn.y) * hi2f(hxn.y));
    float ss = wave_sum(v[0] * v[0] + v[1] * v[1] + v[2] * v[2] + v[3] * v[3]);
    const float rstd = rsqrtf(ss * (1.f / 256.f) + EPS);
    *reinterpret_cast<u32x2*>(p.bufA + (size_t)tok * DM + 768 + ch) =
        mk2(pk2(v[0] * rstd * gn[0], v[1] * rstd * gn[1]), pk2(v[2] * rstd * gn[2], v[3] * rstd * gn[3]));
    gcp = gcc; hxp = hxc; gcc = gcn; hxc = hxn; gbc = gbn;
  }
}

__device__ __forceinline__ void conv_phase(const Params& p, int l, char* smem, int wvi) {
  const int n_ssd = 1040 * 4, n_hy = 1088 * 3;
  for (int it = obid(wvi); it < n_ssd; it += vgrid()) conv_ssd_item(p, l, it, wvi);
  for (int it = obid(wvi); it < n_hy; it += vgrid()) conv_hy_item(p, l, it, smem, wvi);
  shortconv_tokens(p, l, wvi);
}

typedef short s16x4 __attribute__((ext_vector_type(4)));
__device__ __forceinline__ bf16x8 tr8(const bf16_t* T, int stride, int srow0, int col0, int lane) {
  const int quad = lane >> 4, q = (lane & 15) >> 2, pp = lane & 3;
  const bf16_t* a0 = T + (srow0 + 8 * quad + q) * stride + col0 + 4 * pp;
  const s16x4 lo = __builtin_amdgcn_ds_read_tr16_b64_v4i16((GLAS s16x4*)a0);
  const s16x4 hi = __builtin_amdgcn_ds_read_tr16_b64_v4i16((GLAS s16x4*)(a0 + 4 * stride));
  return (bf16x8){lo[0], lo[1], lo[2], lo[3], hi[0], hi[1], hi[2], hi[3]};
}
__device__ __forceinline__ float bperm_f(int src_lane, float v) { return __int_as_float(__builtin_amdgcn_ds_bpermute(src_lane << 2, __float_as_int(v))); }

__device__ __forceinline__ void ssd_scan_item(const Params& p, int l, int item, char* smem, int wvi) {
  const int tid = otid(wvi), lane = tid & 63, w = tid >> 6, l16 = lane & 15, quad = lane >> 4;
  const int wg_ = item >> 1, xcd_ = wg_ & 7, k_ = wg_ >> 3, j_ = k_ & 7, G_ = (k_ >> 3) * 8 + xcd_;
  const int ph = item & 1, dir = j_ & 1, b = G_ >> 1, g = G_ & 1, h = g * 4 + (j_ >> 1);
  const bool last = (l == DEPTH - 1);
  bf16_t* sC = reinterpret_cast<bf16_t*>(smem);
  bf16_t* sB = sC + 64 * 136;
  bf16_t* sXd = sB + 64 * 136;
  bf16_t* sXw = sXd + 64 * 36;
  bf16_t* sM = sXw + 64 * 36;
  bf16_t* sH0 = sM + 64 * 72;
  float* sAcsW = reinterpret_cast<float*>(sH0 + 2 * 32 * 136) + w * 64;
  const bf16_t* pxbc = p.big + (size_t)TA * 1280;
  bf16_t* ydir = p.bufB + (size_t)dir * TA * 512;
  const float aco = -expf(p.a_log[l * 16 + dir * 8 + h]);

  __syncthreads();
  for (int i = tid; i < 2 * 32 * 136 / 8; i += 256) reinterpret_cast<u32x4*>(sH0)[i] = zero_u4();
  f32x4 hacc[2][2];
#pragma unroll
  for (int a = 0; a < 2; ++a)
#pragma unroll
    for (int c = 0; c < 2; ++c) hacc[a][c] = zero4();

  u32x4 rc[4], rb[4], rx; float rdt = 0.f;
  auto chunk_base = [&](int step) -> int {
    if (step < 4) { const int ck = dir ? 3 - step : step; return TL + b * 256 + ck * 64; }
    const int s2 = step - 4; const int ck = dir ? 63 - s2 : s2; return b * 4096 + ck * 64;
  };
  unsigned roff[4]; unsigned xoff, doff;
#pragma unroll
  for (int i = 0; i < 4; ++i) {
    const int slot = tid + 256 * i, row = slot >> 4, c8 = slot & 15;
    roff[i] = (unsigned)((dir ? 63 - row : row) * 1024 + g * 128 + c8 * 8);
  }
  { const int row = tid >> 2, c8 = tid & 3; xoff = (unsigned)((dir ? 63 - row : row) * 1024 + h * 64 + ph * 32 + c8 * 8); }
  doff = (unsigned)((dir ? 63 - lane : lane) * 16 + dir * 8 + h);
  auto issue = [&](int step) {
    const int base = chunk_base(step);
    const bf16_t* cb = pxbc + (size_t)base * 1024;
    const float* db = p.dtb + (size_t)base * 16;
#pragma unroll
    for (int i = 0; i < 4; ++i) {
      rb[i] = *reinterpret_cast<const u32x4*>(cb + 512 + roff[i]);
      rc[i] = *reinterpret_cast<const u32x4*>(cb + 768 + roff[i]);
    }
    rx = *reinterpret_cast<const u32x4*>(cb + xoff);
    rdt = db[doff];
  };
  issue(0);
  const int lidx = 16 * w + l16;
  const unsigned yoff = (unsigned)((dir ? 63 - lidx : lidx) * 512 + h * 64 + ph * 32 + quad * 4);
  float acs = rdt * aco;
#pragma unroll
  for (int o = 1; o < 64; o <<= 1) { const float t = bperm_f(lane - o, acs); acs += (lane >= o) ? t : 0.f; }
  for (int step = 0; step < 68; ++step) {
    const int base = chunk_base(step);
    const bf16_t* sH = sH0 + (step & 1) * (32 * 136);
    bf16_t* sHn = sH0 + ((step + 1) & 1) * (32 * 136);
    __syncthreads();
#pragma unroll
    for (int i = 0; i < 4; ++i) {
      const int slot = tid + 256 * i, row = slot >> 4, c8 = slot & 15;
      *reinterpret_cast<u32x4*>(sC + row * 136 + c8 * 8) = rc[i];
      *reinterpret_cast<u32x4*>(sB + row * 136 + c8 * 8) = rb[i];
    }
    const float dt_cur = rdt;
    const float Atot = __int_as_float(__builtin_amdgcn_readlane(__float_as_int(acs), 63));
    sAcsW[lane] = acs;
    {
      const int row = tid >> 2, c8 = tid & 3;
      const float acs_r = bperm_f(row, acs), dtv = bperm_f(row, dt_cur);
      const float wv = __expf(Atot - acs_r);
      float f[8]; unpack8(rx, f);
      u32x2* d0 = reinterpret_cast<u32x2*>(sXd + row * 36 + c8 * 8);
      u32x2* d1 = reinterpret_cast<u32x2*>(sXw + row * 36 + c8 * 8);
      float a[8];
#pragma unroll
      for (int i = 0; i < 8; ++i) a[i] = f[i] * dtv;
      d0[0] = mk2(pk2(a[0], a[1]), pk2(a[2], a[3])); d0[1] = mk2(pk2(a[4], a[5]), pk2(a[6], a[7]));
      d1[0] = mk2(pk2(a[0] * wv, a[1] * wv), pk2(a[2] * wv, a[3] * wv)); d1[1] = mk2(pk2(a[4] * wv, a[5] * wv), pk2(a[6] * wv, a[7] * wv));
    }
    if (step + 1 < 68) issue(step + 1);
    __syncthreads();
    bf16x8 cfr[4];
#pragma unroll
    for (int kk = 0; kk < 4; ++kk) cfr[kk] = ldfrag(sC + lidx * 136 + kk * 32 + quad * 8);
    const float al = sAcsW[lidx];
    {
#pragma unroll
      for (int st = 0; st < 4; ++st) {
        float m[4];
        {
          f32x4 acc = zero4();
#pragma unroll
          for (int kk = 0; kk < 4; ++kk) acc = mfma16(ldfrag(sB + (16 * st + l16) * 136 + kk * 32 + quad * 8), cfr[kk], acc);
          const float4 as4 = *reinterpret_cast<const float4*>(sAcsW + 16 * st + quad * 4);
          const float asj[4] = {as4.x, as4.y, as4.z, as4.w};
#pragma unroll
          for (int j = 0; j < 4; ++j) {
            const int s = 16 * st + quad * 4 + j;
            const float msk = (s <= lidx) ? 1.f : 0.f;
            m[j] = acc[j] * __expf(fminf(al - asj[j], 0.f)) * msk;
          }
        }
        *reinterpret_cast<u32x2*>(sM + lidx * 72 + 16 * st + quad * 4) = mk2(pk2(m[0], m[1]), pk2(m[2], m[3]));
      }
    }
    {
      const float el = __expf(al);
      bf16_t* yb_ = ydir + (size_t)base * 512;
      bf16x8 mfr[2];
      mfr[0] = ldfrag(sM + lidx * 72 + quad * 8);
      mfr[1] = ldfrag(sM + lidx * 72 + 32 + quad * 8);
#pragma unroll
      for (int pt = 0; pt < 2; ++pt) {
        f32x4 acc = zero4();
#pragma unroll
        for (int kk = 0; kk < 4; ++kk) acc = mfma16(ldfrag(sH + (16 * pt + l16) * 136 + kk * 32 + quad * 8), cfr[kk], acc);
        acc[0] *= el; acc[1] *= el; acc[2] *= el; acc[3] *= el;
        acc = mfma16(tr8(sXd, 36, 0, 16 * pt, lane), mfr[0], acc);
        acc = mfma16(tr8(sXd, 36, 32, 16 * pt, lane), mfr[1], acc);
        *reinterpret_cast<u32x2*>(yb_ + yoff + 16 * pt) =
              mk2(pk2(acc[0], acc[1]), pk2(acc[2], acc[3]));
      }
    }
    {
      const float eT = __expf(Atot);
#pragma unroll
      for (int a = 0; a < 2; ++a)
#pragma unroll
        for (int c = 0; c < 2; ++c) { hacc[a][c][0] *= eT; hacc[a][c][1] *= eT; hacc[a][c][2] *= eT; hacc[a][c][3] *= eT; }
#pragma unroll
      for (int kk = 0; kk < 2; ++kk) {
        bf16x8 af[2], bq[2];
#pragma unroll
        for (int nti = 0; nti < 2; ++nti) af[nti] = tr8(sB, 136, 32 * kk, 16 * (2 * w + nti), lane);
#pragma unroll
        for (int pt = 0; pt < 2; ++pt) bq[pt] = tr8(sXw, 36, 32 * kk, 16 * pt, lane);
#pragma unroll
        for (int nti = 0; nti < 2; ++nti)
#pragma unroll
          for (int pt = 0; pt < 2; ++pt) hacc[nti][pt] = mfma16(af[nti], bq[pt], hacc[nti][pt]);
      }
#pragma unroll
      for (int nti = 0; nti < 2; ++nti)
#pragma unroll
        for (int pt = 0; pt < 2; ++pt) {
          const f32x4 v = hacc[nti][pt];
          *reinterpret_cast<u32x2*>(sHn + (16 * pt + l16) * 136 + 16 * (2 * w + nti) + quad * 4) = mk2(pk2(v[0], v[1]), pk2(v[2], v[3]));
        }
      float nacs = rdt * aco;
#pragma unroll
      for (int o = 1; o < 64; o <<= 1) { const float t = bperm_f(lane - o, nacs); nacs += (lane >= o) ? t : 0.f; }
      acs = nacs;
    }
  }
}

__device__ __forceinline__ void ssd_combine_tokens(const Params& p, int l, int rows, int wvi) {
  const int tid = otid(wvi); const int lane = tid & 63, w = tid >> 6;
  const int nw = vgrid() * 4;
  const int ch = lane * 8;
  const float Dv = p.ssd_d[l * 8 + (lane >> 3)];
  float gn[8];
#pragma unroll
  for (int i = 0; i < 8; ++i) gn[i] = p.mix_gain[l * 1024 + 256 + ch + i];
  const bf16_t* pz = p.big + (size_t)TA * 768;
  const bf16_t* pxbc = p.big + (size_t)TA * 1280;
  const int per = (rows + nw - 1) / nw, gw = obid(wvi) * 4 + w;
  const int r0 = gw * per, r1 = min(rows, r0 + per);
  if (r0 >= r1) return;
  u32x4 nyf, nyb, nxs, nzz;
  auto fetch = [&](int tok) {
    nyf = *reinterpret_cast<const u32x4*>(p.bufB + (size_t)tok * 512 + ch);
    nyb = *reinterpret_cast<const u32x4*>(p.bufB + (size_t)TA * 512 + (size_t)tok * 512 + ch);
    nxs = *reinterpret_cast<const u32x4*>(pxbc + (size_t)tok * 1024 + ch);
    nzz = *reinterpret_cast<const u32x4*>(pz + (size_t)tok * 512 + ch);
  };
  fetch(r0);
  for (int tok = r0; tok < r1; ++tok) {
    float yf[8], yb[8], xs[8], zz[8], v[8];
    unpack8(nyf, yf); unpack8(nyb, yb); unpack8(nxs, xs); unpack8(nzz, zz);
    if (tok + 1 < r1) fetch(tok + 1);
    float ss = 0.f;
#pragma unroll
    for (int i = 0; i < 8; ++i) { v[i] = (yf[i] + yb[i] + Dv * xs[i]) * silu_f(zz[i]); ss += v[i] * v[i]; }
    ss = wave_sum(ss);
    const float rstd = rsqrtf(ss * (1.f / 512.f) + EPS);
#pragma unroll
    for (int i = 0; i < 8; ++i) v[i] *= rstd * gn[i];
    *reinterpret_cast<u32x4*>(p.bufA + (size_t)tok * DM + 256 + ch) = pack8(v);
  }
}

__device__ __forceinline__ void hy_lat_item(const Params& p, int l, int o, int item, char* smem, int wvi) {
  const int tid = otid(wvi), lane = tid & 63, w = tid >> 6, l16 = lane & 15, quad = lane >> 4;
  const int c = item >> 2, bg = item & 3;
  bf16_t* sE = reinterpret_cast<bf16_t*>(smem);
  bf16_t* sO = sE + 8192 + 32;
  bf16_t* sZ = sO + 8192 + 32;
  const float* kf = p.kfl + (size_t)(o * 256 + c) * 8192;
  bf16_t* zrow = p.hyT + (size_t)c * TA;
  const bf16_t* grow = p.hyT + (size_t)((o + 1) * 256 + c) * TA;
  __syncthreads();
  for (int q = tid; q < 8192; q += 256) {
    const bf16_t r = (q == 0) ? (bf16_t)0 : f2bf(kf[8192 - q]);
    sE[q] = r;
    if (q >= 1) sO[q - 1] = r;
  }
  if (tid == 0) sO[8191] = 0;
  if (tid < 36) reinterpret_cast<unsigned*>(sZ + 4 * 4608)[tid] = 0u;
#pragma unroll
  for (int i = 0; i < 8; ++i) {
    const int slot = tid + 256 * i, bl = slot >> 9, s = (slot & 511) * 8;
    const u32x4 v = *reinterpret_cast<const u32x4*>(zrow + (size_t)(bg * 4 + bl) * SEQ + s);
    *reinterpret_cast<u32x4*>(sZ + bl * 4608 + (s >> 6) * 72 + (s & 63)) = v;
  }
  __syncthreads();
  f32x4 acc[4][4];
#pragma unroll
  for (int a = 0; a < 4; ++a)
#pragma unroll
    for (int b2 = 0; b2 < 4; ++b2) acc[a][b2] = zero4();
  const bf16_t* zw = sZ + w * 4608;
  auto ldG = [&](const bf16_t* cp, int q0) -> bf16x8 {
    const unsigned* pp = reinterpret_cast<const unsigned*>(cp + q0);
    u32x4 t = {pp[0], pp[1], pp[2], pp[3]};
    return __builtin_bit_cast(bf16x8, t);
  };
  const bf16_t* cE = sE;
  const bf16_t* cO = sO - 2;
  const int qb = 4096 - 2 * l16 + 8 * quad;
  bf16x8 e_p32 = ldG(cE, qb + 64 * 63 + 32), e_0 = ldG(cE, qb + 64 * 63), e_m32 = ldG(cE, qb + 64 * 63 - 32);
  bf16x8 o_p32 = ldG(cO, qb + 64 * 63 + 32), o_0 = ldG(cO, qb + 64 * 63), o_m32 = ldG(cO, qb + 64 * 63 - 32);
  const bf16_t* zrow0 = sZ + 4 * 4608;
  bf16x8 bcur[4][2], bnxt[4][2];
  auto ldB = [&](int d1v, bf16x8 (&bd)[4][2]) {
#pragma unroll
    for (int nt = 0; nt < 4; ++nt) {
      const int s1 = 16 * nt + l16 - d1v;
      const bf16_t* bp = ((unsigned)s1 < 64u) ? (zw + s1 * 72) : zrow0;
      bd[nt][0] = ldfrag(bp + 8 * quad);
      bd[nt][1] = ldfrag(bp + 32 + 8 * quad);
    }
  };
  ldB(-63, bcur);
#define HY_SEG(D0, D1, NT0, NT1) \
  _Pragma("unroll 1") for (int d1 = (D0); d1 <= (D1); ++d1) { \
    const int dn = (d1 < 63) ? d1 + 1 : 63; \
    const int qn = qb - 64 * dn; \
    const bf16x8 ne0 = ldG(cE, qn), nem = ldG(cE, qn - 32), no0 = ldG(cO, qn), nom = ldG(cO, qn - 32); \
    ldB(dn, bnxt); \
    _Pragma("unroll") for (int nt = (NT0); nt <= (NT1); ++nt) { \
      acc[0][nt] = mfma16(e_0, bcur[nt][0], acc[0][nt]);   acc[1][nt] = mfma16(o_0, bcur[nt][0], acc[1][nt]); \
      acc[2][nt] = mfma16(e_m32, bcur[nt][0], acc[2][nt]); acc[3][nt] = mfma16(o_m32, bcur[nt][0], acc[3][nt]); \
      acc[0][nt] = mfma16(e_p32, bcur[nt][1], acc[0][nt]); acc[1][nt] = mfma16(o_p32, bcur[nt][1], acc[1][nt]); \
      acc[2][nt] = mfma16(e_0, bcur[nt][1], acc[2][nt]);   acc[3][nt] = mfma16(o_0, bcur[nt][1], acc[3][nt]); \
    } \
    e_p32 = e_m32; o_p32 = o_m32; e_0 = ne0; e_m32 = nem; o_0 = no0; o_m32 = nom; \
    _Pragma("unroll") for (int nt = 0; nt < 4; ++nt) { bcur[nt][0] = bnxt[nt][0]; bcur[nt][1] = bnxt[nt][1]; } \
  }
  HY_SEG(-63, -48, 0, 0)
  HY_SEG(-47, -32, 0, 1)
  HY_SEG(-31, -16, 0, 2)
  HY_SEG(-15, 15, 0, 3)
  HY_SEG(16, 31, 1, 3)
  HY_SEG(32, 47, 2, 3)
  HY_SEG(48, 63, 3, 3)
#undef HY_SEG
  const float bias = p.hy_bias[l * 512 + o * 256 + c];
  const int bglob = bg * 4 + w;
#pragma unroll
  for (int h = 0; h < 2; ++h)
#pragma unroll
    for (int nt = 0; nt < 4; ++nt) {
      const int t1 = 16 * nt + l16;
      const f32x4 ye = acc[2 * h][nt], yo = acc[2 * h + 1][nt];
#pragma unroll
      for (int j = 0; j < 4; ++j) {
        const int t2 = 32 * h + 2 * (4 * quad + j);
        const unsigned zo = *reinterpret_cast<const unsigned*>(zw + t1 * 72 + t2);
        const size_t gi = (size_t)bglob * SEQ + t1 * 64 + t2;
        const unsigned gt = *reinterpret_cast<const unsigned*>(grow + gi);
        const float r0 = lo2f(gt) * (ye[j] + bias * lo2f(zo)), r1 = hi2f(gt) * (yo[j] + bias * hi2f(zo));
        *reinterpret_cast<unsigned*>(zrow + gi) = pk2(r0, r1);
      }
    }
}

__device__ __forceinline__ void hy_ctx_item(const Params& p, int l, int o, int item, char* smem, int wvi) {
  const int tid = otid(wvi);
  const int c = item >> 1, bh = item & 1;
  float* sK = reinterpret_cast<float*>(smem);
  float* sZc = sK + 512;
  const float* kf = p.kfc + (size_t)(o * 256 + c) * 512;
  bf16_t* zrow = p.hyT + (size_t)c * TA + TL + bh * 2048;
  const bf16_t* grow = p.hyT + (size_t)((o + 1) * 256 + c) * TA + TL + bh * 2048;
  __syncthreads();
  for (int i = tid; i < 512; i += 256) sK[i] = (i >= 1) ? kf[i] : 0.f;
  for (int i = tid; i < 2048; i += 256) sZc[(i >> 8) * 257 + (i & 255)] = bf2f(zrow[i]);
  __syncthreads();
  const int b = tid >> 5, tq = tid & 31;
  float acc[8];
#pragma unroll
  for (int i = 0; i < 8; ++i) acc[i] = 0.f;
  float tw[8];
#pragma unroll
  for (int i = 0; i < 8; ++i) tw[i] = sK[256 + tq * 8 + i];
#pragma unroll 8
  for (int s = 0; s < 256; ++s) {
    const float zv = sZc[b * 257 + s];
#pragma unroll
    for (int i = 0; i < 8; ++i) acc[i] += tw[i] * zv;
#pragma unroll
    for (int i = 7; i > 0; --i) tw[i] = tw[i - 1];
    tw[0] = sK[(256 + tq * 8 - s - 1) & 511];
  }
  const float bias = p.hy_bias[l * 512 + o * 256 + c];
  float res[8];
#pragma unroll
  for (int i = 0; i < 8; ++i) {
    const int t = tq * 8 + i;
    res[i] = bf2f(grow[b * 256 + t]) * (acc[i] + bias * sZc[b * 257 + t]);
  }
  __syncthreads();
  *reinterpret_cast<u32x4*>(zrow + b * 256 + tq * 8) = pack8(res);
}

__device__ __forceinline__ void hy_final_item(const Params& p, int l, int pi, char* smem, int wvi) {
  const int tid = otid(wvi), lane = tid & 63, w = tid >> 6;
  const int tok0 = pi * 64;
  bf16_t* sZ = reinterpret_cast<bf16_t*>(smem);
  float* sRed = reinterpret_cast<float*>(sZ + 256 * 66);
  float* sRs = sRed + 256;
  __syncthreads();
#pragma unroll
  for (int i = 0; i < 8; ++i) {
    const int slot = tid + 256 * i, c = slot >> 3, part = slot & 7;
    const u32x4 v = *reinterpret_cast<const u32x4*>(p.hyT + (size_t)c * TA + tok0 + part * 8);
    unsigned* d = reinterpret_cast<unsigned*>(sZ + c * 66 + part * 8);
    d[0] = v.x; d[1] = v.y; d[2] = v.z; d[3] = v.w;
  }
  __syncthreads();
  {
    const int t = tid & 63, qd = tid >> 6;
    float ss = 0.f;
    for (int c = qd * 64; c < qd * 64 + 64; ++c) { const float v = bf2f(sZ[c * 66 + t]); ss += v * v; }
    sRed[qd * 64 + t] = ss;
  }
  __syncthreads();
  if (tid < 64) sRs[tid] = rsqrtf((sRed[tid] + sRed[64 + tid] + sRed[128 + tid] + sRed[192 + tid]) * (1.f / 256.f) + EPS);
  __syncthreads();
  const int ch = lane * 4;
  float gn[4];
#pragma unroll
  for (int i = 0; i < 4; ++i) gn[i] = p.mix_gain[l * 1024 + ch + i];
  for (int tt = 0; tt < 16; ++tt) {
    const int t = w * 16 + tt; const float rs = sRs[t];
    const float v0 = bf2f(sZ[(ch + 0) * 66 + t]) * rs * gn[0], v1 = bf2f(sZ[(ch + 1) * 66 + t]) * rs * gn[1];
    const float v2 = bf2f(sZ[(ch + 2) * 66 + t]) * rs * gn[2], v3 = bf2f(sZ[(ch + 3) * 66 + t]) * rs * gn[3];
    *reinterpret_cast<u32x2*>(p.bufA + (size_t)(tok0 + t) * DM + ch) = mk2(pk2(v0, v1), pk2(v2, v3));
  }
}

constexpr int NPHASES = 2 + 13 * DEPTH;

__device__ __forceinline__ void run_phase(const Params& p, int ph, char* smem0, int wvi) {
  char* smem = smem0 + (wvi >> 2) * HALF_LDS;
  if (ph == 0) { prep_phase(p, 0, smem, wvi, 0); return; }
  NormCfg cf;
  if (ph == 1) {
    cf.src_lat = p.x; cf.src_ctx = p.ctx; cf.xs = p.xs; cf.out32 = nullptr; cf.y = nullptr; cf.g_post = nullptr; cf.mod_post = nullptr;
    cf.gate_i = 0; cf.res_w = 0.f; cf.g_pre = p.norm_g; cf.mod_pre = p.mod; cf.shift_i = 0; cf.h = p.bufA; cf.rows = TA;
    norm_phase(cf, wvi); return;
  }
  const int l = (ph - 2) / 13, s = (ph - 2) - l * 13;
  const bool last = (l == DEPTH - 1);
  const float* g = p.norm_g + (size_t)l * 6 * DM;
  const float* modl = p.mod + (size_t)l * MODLAYER;
  const float* xs_lat = (l == 0 && s <= 2) ? p.x : nullptr;
  const float* xs_ctx = (l == 0 && s <= 2) ? p.ctx : nullptr;
  switch (s) {
    case 0: gemm_phase(p, l, p.bufA, p.wFin0, TA, 2 * DFF, DM, EPI_SWIGLU, p.big, smem0, wvi); break;
    case 1: gemm_phase(p, l, p.big, p.wFout0, TA, DM, DFF, EPI_PLAIN, p.bufB, smem0, wvi); break;
    case 2:
      cf.src_lat = xs_lat; cf.src_ctx = xs_ctx; cf.xs = p.xs; cf.out32 = nullptr; cf.y = p.bufB; cf.g_post = g + DM; cf.mod_post = modl;
      cf.gate_i = 2; cf.res_w = 0.5f; cf.g_pre = g + 2 * DM; cf.mod_pre = modl; cf.shift_i = 3; cf.h = p.bufA; cf.rows = TA;
      norm_phase(cf, wvi); break;
    case 3: gemm_phase(p, l, p.bufA, p.wIn, TA, 3328, DM, EPI_INPROJ, nullptr, smem0, wvi); break;
    case 4: conv_phase(p, l, smem, wvi); break;
    case 5: {
      for (int it = obid(wvi); it < 512; it += vgrid()) ssd_scan_item(p, l, it, smem, wvi);
      const int nctx = last ? 0 : 512;
      for (int it = obid(wvi); it < 1024 + nctx; it += vgrid()) {
        if (it < nctx) hy_ctx_item(p, l, 0, it, smem, wvi); else hy_lat_item(p, l, 0, it - nctx, smem, wvi);
      }
    } break;
    case 6: {
      const int nctx = last ? 0 : 512;
      for (int it = obid(wvi); it < 1024 + nctx; it += vgrid()) {
        if (it < nctx) hy_ctx_item(p, l, 1, it, smem, wvi); else hy_lat_item(p, l, 1, it - nctx, smem, wvi);
      }
      ssd_combine_tokens(p, l, last ? TL : TA, wvi);
    } break;
    case 7: {
      const int np = last ? 1024 : 1088;
      for (int it = obid(wvi); it < np; it += vgrid()) hy_final_item(p, l, it, smem, wvi);
    } break;
    case 8: gemm_phase(p, l, p.bufA, p.wOut, last ? TL : TA, DM, DM, EPI_PLAIN, p.bufB, smem0, wvi); break;
    case 9:
      cf.src_lat = nullptr; cf.src_ctx = nullptr; cf.xs = p.xs; cf.out32 = nullptr; cf.y = p.bufB; cf.g_post = g + 3 * DM; cf.mod_post = modl;
      cf.gate_i = 5; cf.res_w = 1.0f; cf.g_pre = g + 4 * DM; cf.mod_pre = modl; cf.shift_i = 6; cf.h = p.bufA; cf.rows = last ? TL : TA;
      norm_phase(cf, wvi); break;
    case 10: gemm_phase(p, l, p.bufA, p.wFin1, last ? TL : TA, 2 * DFF, DM, EPI_SWIGLU, p.big, smem0, wvi); break;
    case 11:
      gemm_phase(p, l, p.big, p.wFout1, last ? TL : TA, DM, DFF, EPI_PLAIN, p.bufB, smem0, wvi);
      if (!last && blockIdx.x >= 64) prep_phase(p, l + 1, smem, wvi, 1);
      break;
    case 12:
      cf.src_lat = nullptr; cf.src_ctx = nullptr; cf.xs = p.xs; cf.out32 = last ? p.out : nullptr; cf.y = p.bufB; cf.g_post = g + 5 * DM; cf.mod_post = modl;
      cf.gate_i = 8; cf.res_w = 0.5f; cf.rows = last ? TL : TA;
      if (!last) { cf.g_pre = g + 6 * DM; cf.mod_pre = modl + MODLAYER; cf.shift_i = 0; cf.h = p.bufA; }
      else { cf.g_pre = nullptr; cf.mod_pre = nullptr; cf.shift_i = 0; cf.h = nullptr; }
      norm_phase(cf, wvi);
      if (!last) prep_phase(p, l + 1, smem, wvi, 2);
      break;
  }
}


#define XB_TMO      128
#define XB_XCNT(j)  (256  + 64 * (j))
#define XB_XSUB(j)  (1280 + 64 * (j))
#define XB_XGEN(j)  (2304 + 64 * (j))
#define XB_TOP      3328
#define XB_TOPGEN   3392
#define XCD_BAR_WORDS 3456
#define XB_SPIN_CAP (1u << 18)
__device__ __forceinline__ unsigned xb_ld(unsigned* p)              { return __hip_atomic_load(p, __ATOMIC_RELAXED, __HIP_MEMORY_SCOPE_AGENT); }
__device__ __forceinline__ unsigned xb_add(unsigned* p, unsigned v) { return __hip_atomic_fetch_add(p, v, __ATOMIC_RELAXED, __HIP_MEMORY_SCOPE_AGENT); }
__device__ __forceinline__ unsigned xb_xcc_id() { return (unsigned)__builtin_amdgcn_s_getreg((3 << 11) | 20) & 0xFu; }
#define XB_SPIN(cond, bar) do { unsigned _sp = 0; while (cond) { __builtin_amdgcn_s_sleep(1); \
    if ((++_sp & 255u) == 0u) { if (xb_ld(&(bar)[XB_TMO])) break; if (_sp > XB_SPIN_CAP) { atomicAdd(&(bar)[XB_TMO], 1u); break; } } } } while (0)
struct XcdBarrier { unsigned* bar; unsigned x; volatile GLAS unsigned* st; };
__device__ __forceinline__ void xcd_barrier_complete(unsigned* bar, unsigned x, unsigned& nloc, unsigned& nx) {
  const unsigned G = gridDim.x * gridDim.y * gridDim.z;
  unsigned sum, cnt, mine, sp = 0u;
  for (;;) {
    sum = 0u; cnt = 0u; mine = 0u;
#pragma unroll
    for (unsigned j = 0; j < 16; ++j) { const unsigned c = xb_ld(&bar[XB_XCNT(j)]); sum += c; cnt += (c > 0u) ? 1u : 0u; mine = (j == x) ? c : mine; }
    if (sum == G) break;
    __builtin_amdgcn_s_sleep(1);
    if ((++sp & 255u) == 0u) { if (xb_ld(&bar[XB_TMO])) break; if (sp > XB_SPIN_CAP) { atomicAdd(&bar[XB_TMO], 1u); break; } }
  }
  nloc = mine > 0u ? mine : 1u; nx = cnt > 0u ? cnt : 1u;
}
__device__ __forceinline__ void xcd_barrier(unsigned* bar_, volatile GLAS unsigned* st_, int wvi) {
  asm volatile("s_waitcnt vmcnt(0)" ::: "memory");
  __syncthreads();
  if (wvi == 0 && lane_id() == 0) {
    XcdBarrier b; b.bar = bar_; b.x = xb_xcc_id(); b.st = st_;
    unsigned* bar = b.bar;
    __builtin_amdgcn_s_waitcnt(0);
    unsigned nloc = b.st[0], nx = b.st[1];
    if (nloc == 0u) { xcd_barrier_complete(bar, b.x, nloc, nx); b.st[0] = nloc; b.st[1] = nx; }
    const unsigned old = xb_add(&bar[XB_XSUB(b.x)], 1u);
    const unsigned gen = old / nloc;
    if (old + 1u == (gen + 1u) * nloc) {
      __builtin_amdgcn_fence(__ATOMIC_RELEASE, "agent");
      asm volatile("s_waitcnt vmcnt(0)" ::: "memory");
      const unsigned og = xb_add(&bar[XB_TOP], 1u);
      const unsigned tg = og / nx;
      if (og + 1u == (tg + 1u) * nx) xb_add(&bar[XB_TOPGEN], 1u);
      else XB_SPIN(xb_ld(&bar[XB_TOPGEN]) == tg, bar);
      __builtin_amdgcn_fence(__ATOMIC_ACQUIRE, "agent");
      xb_add(&bar[XB_XGEN(b.x)], 1u);
      asm volatile("s_waitcnt vmcnt(0)" ::: "memory");
    } else {
      XB_SPIN(xb_ld(&bar[XB_XGEN(b.x)]) == gen, bar);
      __builtin_amdgcn_fence(__ATOMIC_ACQUIRE, "agent");
      asm volatile("s_waitcnt vmcnt(0)" ::: "memory");
    }
  }
  __syncthreads();
}

__global__ void __launch_bounds__(512) mega(Params p) {
  extern __shared__ __attribute__((aligned(16))) char smem[];
  cg::grid_group grid = cg::this_grid();
  const int wvi = __builtin_amdgcn_readfirstlane((int)(threadIdx.x >> 6));
  volatile GLAS unsigned* st = (volatile GLAS unsigned*)(smem + LDS_BYTES);
  if (threadIdx.x == 0) { st[0] = 0u; st[1] = 0u; st[2] = 0u; st[3] = 0u; (void)xb_add(&p.bar[XB_XCNT(xb_xcc_id())], 1u); }
  __syncthreads();
  for (int ph = p.ph_lo; ph < p.ph_hi; ++ph) {
    run_phase(p, ph, smem, wvi);
    if (ph + 1 < p.ph_hi) {
      if (ph == p.ph_lo) grid.sync();
      else xcd_barrier(p.bar, (volatile GLAS unsigned*)(smem + LDS_BYTES), wvi);
    }
  }
}

extern "C" void kernel_launch(void* const* d_in, const int* in_sizes, int n_in, void* d_out, int out_size, void* d_ws, size_t ws_size,
                              hipStream_t stream) {
  static int grid_blocks = 0;
  if (!grid_blocks) {
    int dev = 0, cus = 0, per_cu = 0;
    hipGetDevice(&dev);
    hipDeviceGetAttribute(&cus, hipDeviceAttributeMultiprocessorCount, dev);
    hipFuncSetAttribute((const void*)mega, hipFuncAttributeMaxDynamicSharedMemorySize, LDS_TOTAL);
    hipOccupancyMaxActiveBlocksPerMultiprocessor(&per_cu, (const void*)mega, 512, LDS_TOTAL);
    if (per_cu < 1) per_cu = 1;
    if (per_cu > 1) per_cu = 1;
    grid_blocks = cus * per_cu;
    fprintf(stderr, "kernel_launch: cus %d per_cu %d grid %d ws %zu\n", cus, per_cu, grid_blocks, ws_size);
  }
  Params p;
  memset(&p, 0, sizeof(p));
  const float* const* in = reinterpret_cast<const float* const*>(d_in);
  p.x = in[0]; p.c = in[1]; p.ctx = in[2]; p.c_ctx = in[3]; p.w_mod = in[4]; p.b_mod = in[5]; p.norm_g = in[6];
  p.ffn_w_in = in[7]; p.ffn_w_out = in[8]; p.w_in = in[9]; p.w_out = in[10]; p.hy_conv_w = in[11]; p.hy_conv_b = in[12];
  p.fw1 = in[13]; p.fb1 = in[14]; p.fw2 = in[15]; p.fb2 = in[16]; p.fw3 = in[17]; p.fb3 = in[18]; p.fw4 = in[19];
  p.freq = in[20]; p.hy_bias = in[21]; p.ssd_conv_w = in[22]; p.ssd_conv_b = in[23]; p.a_log = in[24]; p.dt_bias = in[25];
  p.ssd_d = in[26]; p.sc_conv_w = in[27]; p.mix_gain = in[28];
  p.out = reinterpret_cast<float*>(d_out);
  char* ws = reinterpret_cast<char*>(d_ws);
  size_t off = 0;
  auto take = [&](size_t bytes) -> char* { char* r = ws + off; off += (bytes + 255) & ~(size_t)255; return r; };
  p.wFin0 = (bf16_t*)take((size_t)2 * DFF * DM * 2);
  p.wFin1 = (bf16_t*)take((size_t)2 * DFF * DM * 2);
  p.wFout0 = (bf16_t*)take((size_t)DM * DFF * 2);
  p.wFout1 = (bf16_t*)take((size_t)DM * DFF * 2);
  p.wIn = (bf16_t*)take((size_t)3328 * DM * 2);
  p.wOut = (bf16_t*)take((size_t)DM * DM * 2);
  p.bufA = (bf16_t*)take((size_t)TA * DM * 2);
  p.bufB = (bf16_t*)take((size_t)TA * DM * 2);
  p.big = (bf16_t*)take((size_t)TA * 3072 * 2);
  p.hyT = (bf16_t*)take((size_t)3 * 256 * TA * 2);
  p.xs = (bf16_t*)take((size_t)TA * DM * 2);
  p.mod = (float*)take((size_t)DEPTH * MODLAYER * 4);
  p.kfl = (float*)take((size_t)2 * 256 * 8192 * 4);
  p.kfc = (float*)take((size_t)2 * 256 * 512 * 4);
  p.dtb = (float*)take((size_t)TA * 16 * 4);
  p.bar = (unsigned*)take((size_t)XCD_BAR_WORDS * 4);
  if (off > ws_size) { fprintf(stderr, "kernel_launch: workspace too small: need %zu have %zu\n", off, ws_size); return; }
  hipMemsetAsync(p.bar, 0, (size_t)XCD_BAR_WORDS * 4, stream);
#ifndef MK_MULTI
  p.ph_lo = 0; p.ph_hi = NPHASES;
  void* args[] = {&p};
  hipError_t e = hipLaunchCooperativeKernel((const void*)mega, dim3(grid_blocks), dim3(512), args, LDS_TOTAL, stream);
  if (e != hipSuccess) fprintf(stderr, "cooperative launch failed: %s (grid %d)\n", hipGetErrorString(e), grid_blocks);
#else
  for (int ph = 0; ph < NPHASES; ++ph) {
    p.ph_lo = ph; p.ph_hi = ph + 1;
    hipLaunchKernelGGL(mega, dim3(grid_blocks), dim3(512), LDS_TOTAL, stream, p);
  }
#endif
}
```

```cpp
#include <hip/hip_runtime.h>
#include <hip/hip_cooperative_groups.h>
#include <cstdio>
#include <cstring>
namespace cg = cooperative_groups;

typedef unsigned short bf16_t;
typedef short bf16x8 __attribute__((ext_vector_type(8)));
typedef float f32x4 __attribute__((ext_vector_type(4)));
typedef unsigned u32x4 __attribute__((ext_vector_type(4)));
typedef unsigned u32x2 __attribute__((ext_vector_type(2)));
__device__ __forceinline__ u32x4 mk4(unsigned a, unsigned b, unsigned c, unsigned d) { return (u32x4){a, b, c, d}; }
__device__ __forceinline__ u32x4 zero_u4() { unsigned z = 0u; asm volatile("" : "+v"(z)); return (u32x4){z, z, z, z}; }
__device__ __forceinline__ u32x2 mk2(unsigned a, unsigned b) { return (u32x2){a, b}; }

constexpr int NB = 16, SEQ = 4096, DM = 1024, DEPTH = 4, LC = 256;
constexpr int TL = NB * SEQ, TC = NB * LC, TA = TL + TC;
constexpr int DFF = 2816, DIN = 3088;
constexpr int MODROW = 9 * DM;
constexpr int MODLAYER = 17 * MODROW;
constexpr int HALF_LDS = 71680;
constexpr int LDS_BYTES = 2 * HALF_LDS;
constexpr int LDS_TOTAL = LDS_BYTES + 16;
constexpr float EPS = 1e-6f;

struct Params {
  const float *x, *c, *ctx, *c_ctx, *w_mod, *b_mod, *norm_g, *ffn_w_in, *ffn_w_out, *w_in, *w_out;
  const float *hy_conv_w, *hy_conv_b, *fw1, *fb1, *fw2, *fb2, *fw3, *fb3, *fw4, *freq, *hy_bias;
  const float *ssd_conv_w, *ssd_conv_b, *a_log, *dt_bias, *ssd_d, *sc_conv_w, *mix_gain;
  float* out;
  bf16_t *wFin0, *wFin1, *wFout0, *wFout1, *wIn, *wOut;
  bf16_t *bufA, *bufB, *big, *hyT;
  float *mod, *kfl, *kfc, *dtb;
  bf16_t* xs;
  unsigned* bar;
  int ph_lo, ph_hi;
};

#define GLAS __attribute__((address_space(3)))
__device__ __forceinline__ int lane_id() {
  int l; asm volatile("v_mbcnt_lo_u32_b32 %0, -1, 0\n\tv_mbcnt_hi_u32_b32 %0, -1, %0" : "=v"(l)); return l;
}
__device__ __forceinline__ int otid(int wvi) { int t = (wvi & 3) * 64 + lane_id(); asm volatile("" : "+v"(t)); return t; }
__device__ __forceinline__ int obid(int wvi) { int b = __builtin_amdgcn_readfirstlane((int)(blockIdx.x * 2 + (wvi >> 2))); asm volatile("" : "+s"(b)); return b; }
__device__ __forceinline__ int vgrid() { return gridDim.x * 2; }
typedef __bf16 bf16v2_t __attribute__((ext_vector_type(2)));
typedef float f32x2 __attribute__((ext_vector_type(2)));
__device__ __forceinline__ unsigned pk2(float lo, float hi) {
  f32x2 v = {lo, hi};
  bf16v2_t b = __builtin_convertvector(v, bf16v2_t);
  return __builtin_bit_cast(unsigned, b);
}
__device__ __forceinline__ bf16_t f2bf(float f) { return (bf16_t)(pk2(f, 0.f) & 0xffffu); }
__device__ __forceinline__ float bf2f(bf16_t h) { return __uint_as_float(((unsigned)h) << 16); }
__device__ __forceinline__ float lo2f(unsigned u) { return __uint_as_float(u << 16); }
__device__ __forceinline__ float hi2f(unsigned u) { return __uint_as_float(u & 0xffff0000u); }
__device__ __forceinline__ void unpack8(const u32x4& u, float* f) {
  f[0] = lo2f(u.x); f[1] = hi2f(u.x); f[2] = lo2f(u.y); f[3] = hi2f(u.y);
  f[4] = lo2f(u.z); f[5] = hi2f(u.z); f[6] = lo2f(u.w); f[7] = hi2f(u.w);
}
__device__ __forceinline__ u32x4 pack8(const float* f) {
  return mk4(pk2(f[0], f[1]), pk2(f[2], f[3]), pk2(f[4], f[5]), pk2(f[6], f[7]));
}
__device__ __forceinline__ float silu_f(float x) { return x * __builtin_amdgcn_rcpf(1.f + __expf(-x)); }
__device__ __forceinline__ float softplus_f(float x) {
  if (x > 20.f) return x;
  const float e = __expf(x);
  return (e < 0.03f) ? e * (1.f - e * (0.5f - e * (1.f / 3.f - 0.25f * e))) : __logf(1.f + e);
}
__device__ __forceinline__ float wave_sum(float v) {
  const int l4 = lane_id() << 2;
#pragma unroll
  for (int o = 32; o >= 1; o >>= 1) v += __int_as_float(__builtin_amdgcn_ds_bpermute(l4 ^ (o << 2), __float_as_int(v)));
  return v;
}
__device__ __forceinline__ f32x4 zero4() { float z = 0.f; asm volatile("" : "+v"(z)); return (f32x4){z, z, z, z}; }
__device__ __forceinline__ f32x4 mfma16(bf16x8 a, bf16x8 b, f32x4 c) {
  return __builtin_amdgcn_mfma_f32_16x16x32_bf16(a, b, c, 0, 0, 0);
}
__device__ __forceinline__ bf16x8 ldfrag(const bf16_t* p) { return *reinterpret_cast<const bf16x8*>(p); }
__device__ __forceinline__ bf16x8 gather8(const bf16_t* p, int stride) {
  bf16x8 r;
#pragma unroll
  for (int j = 0; j < 8; ++j) r[j] = (short)p[j * stride];
  return r;
}

struct NormCfg {
  const float* src_lat; const float* src_ctx;
  bf16_t* xs;
  float* out32;
  const bf16_t* y; const float* g_post; const float* mod_post; int gate_i; float res_w;
  const float* g_pre; const float* mod_pre; int shift_i; bf16_t* h; int rows;
};

__device__ __forceinline__ void norm_phase(const NormCfg& cf, int wvi) {
  const int tid = otid(wvi); const int lane = tid & 63, w = tid >> 6;
  const int nw = vgrid() * 4, gw = obid(wvi) * 4 + w;
  const int per = (cf.rows + nw - 1) / nw;
  const int wv8 = (gw & 7);
  const int r0 = (gw >> 3) * per * 8 + wv8, r1 = min(cf.rows, (gw >> 3) * per * 8 + per * 8);
  if (r0 >= r1) return;
  const bool has_post = cf.y != nullptr, has_pre = cf.h != nullptr;
  const bool src32 = cf.src_lat != nullptr;
  auto ld8 = [&](const float* base, int i, float* d) {
    const float4 a = reinterpret_cast<const float4*>(base)[2 * (lane + 64 * i)];
    const float4 c = reinterpret_cast<const float4*>(base)[2 * (lane + 64 * i) + 1];
    d[0] = a.x; d[1] = a.y; d[2] = a.z; d[3] = a.w; d[4] = c.x; d[5] = c.y; d[6] = c.z; d[7] = c.w;
  };
  float gpo[2][8], gpr[2][8], gate[2][8], sh[2][8], sc[2][8];
#pragma unroll
  for (int i = 0; i < 2; ++i) {
#pragma unroll
    for (int k = 0; k < 8; ++k) { gpo[i][k] = 0.f; gpr[i][k] = 0.f; gate[i][k] = 0.f; sh[i][k] = 0.f; sc[i][k] = 0.f; }
    if (has_post) ld8(cf.g_post, i, gpo[i]);
    if (has_pre) ld8(cf.g_pre, i, gpr[i]);
  }
  int cur_m = -1;
  struct RowRegs { float4 xn[2][2]; u32x4 xb[2], yn[2]; };
  RowRegs Q0, Q1;
  auto fetch = [&](int row, RowRegs& Q) {
    if (src32) {
      const float* src = (row < TL) ? cf.src_lat + (size_t)row * DM : cf.src_ctx + (size_t)(row - TL) * DM;
#pragma unroll
      for (int i = 0; i < 2; ++i) {
        Q.xn[i][0] = reinterpret_cast<const float4*>(src)[2 * (lane + 64 * i)];
        Q.xn[i][1] = reinterpret_cast<const float4*>(src)[2 * (lane + 64 * i) + 1];
      }
    } else {
      const u32x4* xp = reinterpret_cast<const u32x4*>(cf.xs + (size_t)row * DM);
#pragma unroll
      for (int i = 0; i < 2; ++i) Q.xb[i] = xp[lane + 64 * i];
    }
    if (has_post) {
      const u32x4* yp = reinterpret_cast<const u32x4*>(cf.y + (size_t)row * DM);
#pragma unroll
      for (int i = 0; i < 2; ++i) Q.yn[i] = yp[lane + 64 * i];
    }
  };
  fetch(r0, Q0);
  if (r0 + 8 < r1) fetch(r0 + 8, Q1);
  for (int row = r0; row < r1; row += 8) {
    float xv[2][8], yv[2][8];
#pragma unroll
    for (int i = 0; i < 2; ++i) {
      if (src32) {
        xv[i][0] = Q0.xn[i][0].x; xv[i][1] = Q0.xn[i][0].y; xv[i][2] = Q0.xn[i][0].z; xv[i][3] = Q0.xn[i][0].w;
        xv[i][4] = Q0.xn[i][1].x; xv[i][5] = Q0.xn[i][1].y; xv[i][6] = Q0.xn[i][1].z; xv[i][7] = Q0.xn[i][1].w;
      } else unpack8(Q0.xb[i], xv[i]);
      unpack8(Q0.yn[i], yv[i]);
    }
    Q0 = Q1;
    if (row + 16 < r1) fetch(row + 16, Q1);
    const int mrow = (row < TL) ? (row >> 12) : 16;
    if (mrow != cur_m) {
      cur_m = mrow;
#pragma unroll
      for (int i = 0; i < 2; ++i) {
        if (has_post) ld8(cf.mod_post + (size_t)mrow * MODROW + cf.gate_i * DM, i, gate[i]);
        if (has_pre) {
          ld8(cf.mod_pre + (size_t)mrow * MODROW + cf.shift_i * DM, i, sh[i]);
          ld8(cf.mod_pre + (size_t)mrow * MODROW + (cf.shift_i + 1) * DM, i, sc[i]);
        }
      }
    }
    if (has_post) {
      float ss = 0.f;
#pragma unroll
      for (int i = 0; i < 2; ++i)
#pragma unroll
        for (int k = 0; k < 8; ++k) ss += yv[i][k] * yv[i][k];
      ss = wave_sum(ss);
      const float rstd = rsqrtf(ss * (1.f / DM) + EPS) * cf.res_w;
#pragma unroll
      for (int i = 0; i < 2; ++i)
#pragma unroll
        for (int k = 0; k < 8; ++k) xv[i][k] += gate[i][k] * gpo[i][k] * yv[i][k] * rstd;
      if (cf.out32) {
        float4* op = reinterpret_cast<float4*>(cf.out32 + (size_t)row * DM);
#pragma unroll
        for (int i = 0; i < 2; ++i) {
          op[2 * (lane + 64 * i)] = make_float4(xv[i][0], xv[i][1], xv[i][2], xv[i][3]);
          op[2 * (lane + 64 * i) + 1] = make_float4(xv[i][4], xv[i][5], xv[i][6], xv[i][7]);
        }
      } else {
        u32x4* xp = reinterpret_cast<u32x4*>(cf.xs + (size_t)row * DM);
#pragma unroll
        for (int i = 0; i < 2; ++i) {
          const u32x4 pk = pack8(xv[i]);
          xp[lane + 64 * i] = pk;
          unpack8(pk, xv[i]);
        }
      }
    }
    if (has_pre) {
      float ss = 0.f;
#pragma unroll
      for (int i = 0; i < 2; ++i)
#pragma unroll
        for (int k = 0; k < 8; ++k) ss += xv[i][k] * xv[i][k];
      ss = wave_sum(ss);
      const float rstd = rsqrtf(ss * (1.f / DM) + EPS);
      u32x4* hp = reinterpret_cast<u32x4*>(cf.h + (size_t)row * DM);
#pragma unroll
      for (int i = 0; i < 2; ++i) {
        float hv[8];
#pragma unroll
        for (int k = 0; k < 8; ++k) hv[k] = xv[i][k] * rstd * gpr[i][k] * (1.f + sc[i][k]) + sh[i][k];
        hp[lane + 64 * i] = pack8(hv);
      }
    }
  }
}

enum { EPI_PLAIN = 0, EPI_SWIGLU = 1, EPI_INPROJ = 2 };
constexpr int GBM = 256, GBK = 64, GHALF = 128, GHT = GHALF * GBK, GNXCD = 8, GWGM = 8;

__device__ __forceinline__ int lds_byte(int r, int c) {
  const int st = (r >> 4) * 2 + (c >> 5), rr = r & 15, cc = c & 31, ob = rr * 64 + cc * 2;
  return st * 1024 + (ob ^ (((ob >> 9) & 1) << 5));
}
__device__ __forceinline__ void stage_rc(int b, int& R, int& C) {
  const int st = b / 1024, sb = b % 1024, swz = sb ^ (((sb >> 9) & 1) << 5);
  R = (st >> 1) * 16 + swz / 64; C = (st & 1) * 32 + (swz % 64) / 2;
}

__device__ __forceinline__ void gemm_phase(const Params& p, int l, const bf16_t* __restrict__ A, const bf16_t* __restrict__ Bt, int M, int N, int K,
                           int epi, bf16_t* __restrict__ outp, char* smem, int wvi) {
  GLAS unsigned char* lds = (GLAS unsigned char*)smem;
  const int wid = wvi; int tidx = wvi * 64 + lane_id(); asm volatile("" : "+v"(tidx));
  const int lane = tidx & 63, wr = wid >> 2, wc = wid & 3, fr = lane & 15, fq = lane >> 4;
  const int nt = K / GBK;
  unsigned voff[2];
#pragma unroll
  for (int i = 0; i < 2; ++i) { int R, C; stage_rc(tidx * 16 + i * 8192, R, C); voff[i] = (unsigned)(R * K + C) * 2u; }
  const size_t kstep = (size_t)(GBK * 2), hstep = (size_t)GHALF * K * 2, tstep = 2 * hstep;
  const unsigned ldsw = (unsigned)wid * 1024u;
  const int aoff = lds_byte(wr * 64 + fr, fq * 8), boff = lds_byte(wc * 32 + fr, fq * 8);
  constexpr int HTB = GHT * 2;
#define G_SA(b, h) (((b) * 2 + (h)) * HTB)
#define G_SB(b, h) ((4 + (b) * 2 + (h)) * HTB)
#define G_STAGE(bufoff, gbase) do { _Pragma("unroll") for (int _i = 0; _i < 2; ++_i) \
    __builtin_amdgcn_global_load_lds((const unsigned*)((const char*)(gbase) + voff[_i]), (GLAS unsigned*)(lds + (bufoff) + ldsw + _i * 8192), 16, 0, 0); } while (0)
#define G_LDA(dst, b, h) do { _Pragma("unroll") for (int m = 0; m < 4; ++m) _Pragma("unroll") for (int k = 0; k < 2; ++k) \
    dst[m][k] = *(const GLAS bf16x8*)(lds + G_SA(b, h) + aoff + m * 2048 + k * 1024); } while (0)
#define G_LDB(dst, b, h) do { _Pragma("unroll") for (int n = 0; n < 2; ++n) _Pragma("unroll") for (int k = 0; k < 2; ++k) \
    dst[n][k] = *(const GLAS bf16x8*)(lds + G_SB(b, h) + boff + n * 2048 + k * 1024); } while (0)
#define G_MMA(ai, bj, At_, Bt_) do { __builtin_amdgcn_s_setprio(1); \
    _Pragma("unroll") for (int m = 0; m < 4; ++m) _Pragma("unroll") for (int n = 0; n < 2; ++n) _Pragma("unroll") for (int k = 0; k < 2; ++k) \
      acc[ai][bj][m][n] = __builtin_amdgcn_mfma_f32_16x16x32_bf16(Bt_[n][k], At_[m][k], acc[ai][bj][m][n], 0, 0, 0); \
    __builtin_amdgcn_s_setprio(0); } while (0)
#define G_WAIT_V(n) asm volatile("s_waitcnt vmcnt(" #n ")" ::: "memory")
#define G_WAIT_L(n) asm volatile("s_waitcnt lgkmcnt(" #n ")" ::: "memory")
#define G_BAR __builtin_amdgcn_s_barrier()
#define G_SCHED __builtin_amdgcn_sched_barrier(0)
  const int nM = M / GBM, nN = N / GBM, nwg = nM * nN;
  auto tile_of = [&](int Lw, int& pm_, int& pn_) {
    int wgid = Lw;
    { const int q = nwg / GNXCD, r = nwg % GNXCD, xcd = wgid % GNXCD, off = wgid / GNXCD; wgid = (xcd < r ? xcd * (q + 1) : r * (q + 1) + (xcd - r) * q) + off; }
    const int nig = GWGM * nN, gid = wgid / nig, fm = gid * GWGM, gsz = min(nM - fm, GWGM);
    pm_ = fm + ((wgid % nig) % gsz); pn_ = (wgid % nig) / gsz;
  };
  int Lw = blockIdx.x;
  if (Lw < nwg) {
    int pm, pn; tile_of(Lw, pm, pn);
    const char* cA = (const char*)A + (size_t)pm * tstep;
    const char* cB = (const char*)Bt + (size_t)pn * tstep;
    f32x4 acc[2][2][4][2];
#pragma unroll
    for (int a = 0; a < 2; ++a)
#pragma unroll
      for (int b = 0; b < 2; ++b)
#pragma unroll
        for (int m = 0; m < 4; ++m)
#pragma unroll
          for (int n = 0; n < 2; ++n) acc[a][b][m][n] = zero4();
    bf16x8 At[4][2], B0[2][2], B1[2][2];
    G_STAGE(G_SB(0, 0), cB); G_STAGE(G_SA(0, 0), cA); G_STAGE(G_SB(0, 1), cB + hstep); G_STAGE(G_SA(0, 1), cA + hstep);
    if (wr == 1) G_BAR;
    G_WAIT_V(4); G_BAR;
    G_STAGE(G_SB(1, 0), cB + kstep); G_STAGE(G_SA(1, 0), cA + kstep); G_STAGE(G_SB(1, 1), cB + hstep + kstep);
    G_WAIT_V(6); G_BAR;
    for (;;) {
      const int Ln = Lw + gridDim.x;
      const bool has_next = Ln < nwg;
      int npm = pm, npn = pn;
      if (has_next) tile_of(Ln, npm, npn);
      const char* nA = (const char*)A + (size_t)npm * tstep; const char* nB = (const char*)Bt + (size_t)npn * tstep;
      for (int t = 0; t < nt; t += 2) {
        const bool lastt = (t == nt - 2);
        const char* a1 = cA + (size_t)(t + 1) * kstep;
        const char* a2 = lastt ? nA : cA + (size_t)(t + 2) * kstep; const char* b2 = lastt ? nB : cB + (size_t)(t + 2) * kstep;
        const char* a3 = a2 + kstep; const char* b3 = b2 + kstep;
        G_LDB(B0, 0, 0); G_SCHED; G_LDA(At, 0, 0); G_STAGE(G_SA(1, 1), a1 + hstep);
        G_WAIT_L(8); G_BAR; G_WAIT_L(0); G_MMA(0, 0, At, B0); G_BAR; G_SCHED;
        G_LDB(B1, 0, 1); G_STAGE(G_SB(0, 0), b2);
        G_BAR; G_WAIT_L(0); G_MMA(0, 1, At, B1); G_BAR;
        G_LDA(At, 0, 1); G_STAGE(G_SA(0, 0), a2);
        G_BAR; G_WAIT_L(0); G_MMA(1, 0, At, B0); G_BAR; G_SCHED;
        G_STAGE(G_SB(0, 1), b2 + hstep);
        G_WAIT_V(6); G_BAR; G_MMA(1, 1, At, B1); G_BAR;
        G_LDB(B0, 1, 0); G_SCHED; G_LDA(At, 1, 0); G_STAGE(G_SA(0, 1), a2 + hstep);
        G_WAIT_L(8); G_BAR; G_WAIT_L(0); G_MMA(0, 0, At, B0); G_BAR; G_SCHED;
        G_LDB(B1, 1, 1); G_STAGE(G_SB(1, 0), b3);
        G_BAR; G_WAIT_L(0); G_MMA(0, 1, At, B1); G_BAR;
        G_LDA(At, 1, 1); G_STAGE(G_SA(1, 0), a3);
        G_BAR; G_WAIT_L(0); G_MMA(1, 0, At, B0); G_BAR; G_SCHED;
        G_STAGE(G_SB(1, 1), b3 + hstep);
        G_WAIT_V(6); G_BAR; G_MMA(1, 1, At, B1); G_BAR;
      }
      const int brow = pm * GBM, bcol = pn * GBM;
    const int r0 = brow + wr * 64 + fr;
    if (epi == EPI_PLAIN) {
#pragma unroll
      for (int ai = 0; ai < 2; ++ai)
#pragma unroll
        for (int m = 0; m < 4; ++m) {
          bf16_t* rp = outp + (size_t)(r0 + ai * GHALF + m * 16) * N + bcol + wc * 32 + fq * 8;
#pragma unroll
          for (int bj = 0; bj < 2; ++bj) {
            const f32x4 v0 = acc[ai][bj][m][0], v1 = acc[ai][bj][m][1];
            *reinterpret_cast<u32x4*>(rp + bj * GHALF) = mk4(pk2(v0[0], v0[1]), pk2(v0[2], v0[3]), pk2(v1[0], v1[1]), pk2(v1[2], v1[3]));
          }
        }
    } else if (epi == EPI_SWIGLU) {
#pragma unroll
      for (int ai = 0; ai < 2; ++ai)
#pragma unroll
        for (int m = 0; m < 4; ++m) {
          bf16_t* rp = outp + (size_t)(r0 + ai * GHALF + m * 16) * DFF + pn * 128 + wc * 32 + fq * 8;
          unsigned pk[4];
#pragma unroll
          for (int bj = 0; bj < 2; ++bj) {
            const f32x4 g = acc[ai][bj][m][0], u = acc[ai][bj][m][1];
            const float o0 = silu_f(g[0]) * u[0], o1 = silu_f(g[1]) * u[1], o2 = silu_f(g[2]) * u[2], o3 = silu_f(g[3]) * u[3];
            pk[2 * bj] = pk2(o0, o1); pk[2 * bj + 1] = pk2(o2, o3);
          }
          *reinterpret_cast<u32x4*>(rp) = mk4(pk[0], pk[1], pk[2], pk[3]);
        }
    } else {
      if (pn < 12) {
        bf16_t* dst; int ld, c0;
        if (pn < 3) { dst = p.big; ld = 768; c0 = pn * 256; }
        else if (pn < 5) { dst = p.big + (size_t)TA * 768; ld = 512; c0 = (pn - 3) * 256; }
        else if (pn < 9) { dst = p.big + (size_t)TA * 1280; ld = 1024; c0 = (pn - 5) * 256; }
        else { dst = p.big + (size_t)TA * 2304; ld = 768; c0 = (pn - 9) * 256; }
#pragma unroll
        for (int ai = 0; ai < 2; ++ai)
#pragma unroll
          for (int m = 0; m < 4; ++m) {
            bf16_t* rp = dst + (size_t)(r0 + ai * GHALF + m * 16) * ld + c0 + wc * 32 + fq * 8;
#pragma unroll
            for (int bj = 0; bj < 2; ++bj) {
              const f32x4 v0 = acc[ai][bj][m][0], v1 = acc[ai][bj][m][1];
              *reinterpret_cast<u32x4*>(rp + bj * GHALF) = mk4(pk2(v0[0], v0[1]), pk2(v0[2], v0[3]), pk2(v1[0], v1[1]), pk2(v1[2], v1[3]));
            }
          }
      } else if (wc == 0 && fq < 2) {
        const float* db = p.dt_bias + l * 16 + fq * 8;
        float dbv[8];
#pragma unroll
        for (int i = 0; i < 8; ++i) dbv[i] = db[i];
#pragma unroll
        for (int ai = 0; ai < 2; ++ai)
#pragma unroll
          for (int m = 0; m < 4; ++m) {
            const f32x4 v0 = acc[ai][0][m][0], v1 = acc[ai][0][m][1];
            float4 o0, o1;
            o0.x = softplus_f(v0[0] + dbv[0]); o0.y = softplus_f(v0[1] + dbv[1]); o0.z = softplus_f(v0[2] + dbv[2]); o0.w = softplus_f(v0[3] + dbv[3]);
            o1.x = softplus_f(v1[0] + dbv[4]); o1.y = softplus_f(v1[1] + dbv[5]); o1.z = softplus_f(v1[2] + dbv[6]); o1.w = softplus_f(v1[3] + dbv[7]);
            float* dp = p.dtb + (size_t)(r0 + ai * GHALF + m * 16) * 16 + fq * 8;
            *reinterpret_cast<float4*>(dp) = o0;
            *reinterpret_cast<float4*>(dp + 4) = o1;
          }
      }
    }
      if (!has_next) break;
#pragma unroll
      for (int a = 0; a < 2; ++a)
#pragma unroll
        for (int b = 0; b < 2; ++b)
#pragma unroll
          for (int m = 0; m < 4; ++m)
#pragma unroll
            for (int n = 0; n < 2; ++n) acc[a][b][m][n] = zero4();
      Lw = Ln; pm = npm; pn = npn; cA = nA; cB = nB;
    }
    G_WAIT_V(0);
    if (wr == 0) G_BAR;
    G_BAR;
  }
  __syncthreads();
#undef G_SA
#undef G_SB
#undef G_STAGE
#undef G_LDA
#undef G_LDB
#undef G_MMA
#undef G_WAIT_V
#undef G_WAIT_L
#undef G_BAR
#undef G_SCHED
}

__device__ __forceinline__ void prep_filter_item(const Params& p, int l, int it, char* smem, int wvi) {
  const int tid = otid(wvi);
  int pos0, L;
  if (it < 256) { pos0 = it * 16; L = SEQ; } else { pos0 = (it - 256) * 16; L = LC; }
  const float inv_lm1 = (L == SEQ) ? (1.f / (float)(SEQ - 1)) : (1.f / (float)(LC - 1));
  const double inv_l = (L == SEQ) ? (1.0 / (double)SEQ) : (1.0 / (double)LC);
  float* sF = reinterpret_cast<float*>(smem);
  float* sH1 = sF + 16 * 33;
  float* sH2 = sH1 + 16 * 64;
  float* sH3 = sH2 + 16 * 64;
  __syncthreads();
  for (int idx = tid; idx < 16 * 33; idx += 256) {
    const int ps = idx / 33, k = idx - ps * 33;
    const int i = pos0 + ps;
    float v;
    if (k == 0) v = (float)i * inv_lm1;
    else {
      const int j = (k - 1) & 15;
      const double f = 1e-4 + (double)j * ((15.0 - 1e-4) / 15.0);
      double r = f * (double)i * inv_l;
      r -= floor(r);
      const float ang = 6.283185307179586f * (float)r;
      v = (k <= 16) ? cosf(ang) : -sinf(ang);
    }
    sF[idx] = v;
  }
  __syncthreads();
  const int u = tid & 63, pg = tid >> 6;
  const float fr = p.freq[l * 64 + u];
  {
    const float* W = p.fw1 + (size_t)l * 33 * 64; const float bb = p.fb1[l * 64 + u];
#pragma unroll 1
    for (int q = 0; q < 4; ++q) {
      const int ps = pg * 4 + q; float a = bb;
      for (int k = 0; k < 33; ++k) a += sF[ps * 33 + k] * W[k * 64 + u];
      sH1[ps * 64 + u] = sinf(fr * a);
    }
  }
  __syncthreads();
  {
    const float* W = p.fw2 + (size_t)l * 64 * 64; const float bb = p.fb2[l * 64 + u];
#pragma unroll 1
    for (int q = 0; q < 4; ++q) {
      const int ps = pg * 4 + q; float a = bb;
      for (int k = 0; k < 64; ++k) a += sH1[ps * 64 + k] * W[k * 64 + u];
      sH2[ps * 64 + u] = sinf(fr * a);
    }
  }
  __syncthreads();
  {
    const float* W = p.fw3 + (size_t)l * 64 * 64; const float bb = p.fb3[l * 64 + u];
#pragma unroll 1
    for (int q = 0; q < 4; ++q) {
      const int ps = pg * 4 + q; float a = bb;
      for (int k = 0; k < 64; ++k) a += sH2[ps * 64 + k] * W[k * 64 + u];
      sH3[ps * 64 + u] = sinf(fr * a);
    }
  }
  __syncthreads();
  const float* W4 = p.fw4 + (size_t)l * 64 * 1024;
  const float a0 = -3.0701134573253944f, a1 = -15.350567286626972f;
  for (int cc = 0; cc < 4; ++cc) {
    const int col = tid + 256 * cc;
    const int o = col >> 9, dr = (col >> 8) & 1, ch = col & 255;
    const float dl = fabsf(a0 + (float)ch * ((a1 - a0) / 255.f));
    for (int half = 0; half < 2; ++half) {
      float acc[8];
#pragma unroll
      for (int q = 0; q < 8; ++q) acc[q] = 0.f;
      for (int k = 0; k < 64; ++k) {
        const float wv = W4[k * 1024 + col];
#pragma unroll
        for (int q = 0; q < 8; ++q) acc[q] += sH3[(half * 8 + q) * 64 + k] * wv;
      }
#pragma unroll
      for (int q = 0; q < 8; ++q) {
        const int i = pos0 + half * 8 + q;
        const float t = (float)i * inv_lm1;
        const float v = acc[q] * expf(-t * dl);
        float* kb = (L == SEQ) ? p.kfl + (size_t)(o * 256 + ch) * 8192 : p.kfc + (size_t)(o * 256 + ch) * 512;
        const int mid = (L == SEQ) ? 4096 : 256;
        const int idx = (dr == 0) ? mid + i : ((i >= 1) ? mid - i : 0);
        kb[idx] = v;
      }
    }
  }
}

__device__ __forceinline__ void prep_mod_item(const Params& p, int it, char* smem, int wvi) {
  const int tid = otid(wvi), lane = tid & 63, w = tid >> 6;
  const int l2 = it / 144, col0 = (it - l2 * 144) * 64;
  float* sS = reinterpret_cast<float*>(smem);
  float* sR = sS + 17 * 256;
  float acc[17];
#pragma unroll
  for (int m = 0; m < 17; ++m) acc[m] = 0.f;
  for (int kc = 0; kc < 4; ++kc) {
    __syncthreads();
    for (int idx = tid; idx < 17 * 256; idx += 256) {
      const int m = idx >> 8, k = idx & 255;
      const float v = (m < 16) ? p.c[m * DM + kc * 256 + k] : p.c_ctx[kc * 256 + k];
      sS[idx] = v * __builtin_amdgcn_rcpf(1.f + expf(-v));
    }
    __syncthreads();
    const float* Wp = p.w_mod + ((size_t)l2 * DM + kc * 256 + w * 64) * MODROW + col0 + lane;
    for (int kk = 0; kk < 64; ++kk) {
      const float wv = Wp[(size_t)kk * MODROW];
      const float* sp = sS + w * 64 + kk;
#pragma unroll
      for (int m = 0; m < 17; ++m) acc[m] += sp[m * 256] * wv;
    }
  }
  __syncthreads();
#pragma unroll
  for (int m = 0; m < 17; ++m) sR[(w * 17 + m) * 64 + lane] = acc[m];
  __syncthreads();
  for (int idx = tid; idx < 17 * 64; idx += 256) {
    const int m = idx >> 6, cl = idx & 63;
    float s = p.b_mod[l2 * MODROW + col0 + cl];
#pragma unroll
    for (int ww = 0; ww < 4; ++ww) s += sR[(ww * 17 + m) * 64 + cl];
    p.mod[(size_t)(l2 * 17 + m) * MODROW + col0 + cl] = s;
  }
}

__device__ __forceinline__ int perm32(int rho) { const int n = rho >> 4, i = rho & 15; return 8 * (i >> 2) + 4 * n + (i & 3); }
__device__ __forceinline__ int srccol(int mode, int n) {
  if (mode == 0) return (n & ~31) + perm32(n & 31);
  if (mode == 1) {
    const int tile = n >> 8, r = n & 255, bj = r >> 7, wc = (r >> 5) & 3, q = (r >> 4) & 1, i = r & 15;
    return (q ? DFF : 0) + tile * 128 + wc * 32 + (i >> 2) * 8 + bj * 4 + (i & 3);
  }
  const int L = (n & ~31) + perm32(n & 31);
  if (L < 2304) return L;
  if (L < 3072) return L + 16;
  if (L < 3088) return L - 768;
  return -1;
}

__device__ __forceinline__ void prep_conv_item(const Params& p, int l, int it, char* smem, int wvi) {
  const int tid = otid(wvi);
  const float* src; bf16_t* dst; int ld, K, mode, KT;
  if (it < 2816) { const int i = it / 1408; it -= i * 1408; src = p.ffn_w_in + (size_t)(l * 2 + i) * DM * 2 * DFF; dst = i ? p.wFin1 : p.wFin0; ld = 2 * DFF; K = DM; mode = 1; KT = 16; }
  else if (it < 4224) { it -= 2816; const int i = it / 704; it -= i * 704; src = p.ffn_w_out + (size_t)(l * 2 + i) * DFF * DM; dst = i ? p.wFout1 : p.wFout0; ld = DM; K = DFF; mode = 0; KT = 44; }
  else if (it < 5056) { it -= 4224; src = p.w_in + (size_t)l * DM * DIN; dst = p.wIn; ld = DIN; K = DM; mode = 2; KT = 16; }
  else { it -= 5056; src = p.w_out + (size_t)l * DM * DM; dst = p.wOut; ld = DM; K = DM; mode = 0; KT = 16; }
  const int ntile = it / KT, ktile = it - ntile * KT;
  const int n0 = ntile * 64, k0 = ktile * 64;
  float* sT = reinterpret_cast<float*>(smem);
  __syncthreads();
#pragma unroll 4
  for (int i = 0; i < 16; ++i) {
    const int idx = tid + 256 * i, k = idx >> 6, n = idx & 63;
    const int sc = srccol(mode, n0 + n);
    sT[k * 65 + n] = (sc >= 0) ? src[(size_t)(k0 + k) * ld + sc] : 0.f;
  }
  __syncthreads();
#pragma unroll
  for (int i = 0; i < 2; ++i) {
    const int idx = tid + 256 * i, n = idx >> 3, kg = idx & 7;
    float f[8];
#pragma unroll
    for (int j = 0; j < 8; ++j) f[j] = sT[(kg * 8 + j) * 65 + n];
    *reinterpret_cast<u32x4*>(dst + (size_t)(n0 + n) * K + k0 + kg * 8) = pack8(f);
  }
}

enum { PS_FILT = 1, PS_MOD = 2, PS_FIN0 = 4, PS_FIN1 = 8, PS_FOUT0 = 16, PS_FOUT1 = 32, PS_WIN = 64, PS_WOUT = 128, PS_ALLCONV = 4 | 8 | 16 | 32 | 64 | 128 };
__device__ __forceinline__ void prep_sub(const Params& p, int l, char* smem, int wvi, int vb, int nvb, int mask) {
  int off = 0;
  auto start = [&](int n) -> int { int j = (vb - off) % nvb; if (j < 0) j += nvb; off = (off + n) % nvb; return j; };
  if (mask & PS_FILT) for (int j = start(272); j < 272; j += nvb) prep_filter_item(p, l, j, smem, wvi);
  if (mask & PS_MOD) for (int j = start(576); j < 576; j += nvb) prep_mod_item(p, j, smem, wvi);
  if (mask & PS_FIN0) for (int j = start(1408); j < 1408; j += nvb) prep_conv_item(p, l, j, smem, wvi);
  if (mask & PS_FIN1) for (int j = start(1408); j < 1408; j += nvb) prep_conv_item(p, l, 1408 + j, smem, wvi);
  if (mask & PS_FOUT0) for (int j = start(704); j < 704; j += nvb) prep_conv_item(p, l, 2816 + j, smem, wvi);
  if (mask & PS_FOUT1) for (int j = start(704); j < 704; j += nvb) prep_conv_item(p, l, 3520 + j, smem, wvi);
  if (mask & PS_WIN) for (int j = start(832); j < 832; j += nvb) prep_conv_item(p, l, 4224 + j, smem, wvi);
  if (mask & PS_WOUT) for (int j = start(256); j < 256; j += nvb) prep_conv_item(p, l, 5056 + j, smem, wvi);
}

__device__ __forceinline__ void conv_ssd_item(const Params& p, int l, int item, int wvi) {
  const int sg = item >> 2, cc = item & 3;
  const int tid = otid(wvi), cg8 = tid & 31, pc = tid >> 5;
  const int col = cc * 256 + cg8 * 8;
  int segbase, PL;
  if (sg < 1024) { segbase = sg * 64; PL = 8; } else { segbase = TL + (sg - 1024) * 256; PL = 32; }
  bf16_t* base = p.big + (size_t)TA * 1280 + (size_t)segbase * 1024 + col;
  float w0[8], w1[8], w2[8], bb[8];
  {
    const float* cw = p.ssd_conv_w + (size_t)l * 3 * 1024 + col;
    const float* cb = p.ssd_conv_b + (size_t)l * 1024 + col;
#pragma unroll
    for (int i = 0; i < 8; ++i) { w0[i] = cw[i]; w1[i] = cw[1024 + i]; w2[i] = cw[2048 + i]; bb[i] = cb[i]; }
  }
  const int r0 = pc * PL;
  const u32x4 zero = zero_u4();
  const u32x4 hprev = (pc > 0) ? *reinterpret_cast<const u32x4*>(base + (size_t)(r0 - 1) * 1024) : zero;
  const u32x4 hnext = (pc < 7) ? *reinterpret_cast<const u32x4*>(base + (size_t)(r0 + PL) * 1024) : zero;
  const u32x4 cur0 = *reinterpret_cast<const u32x4*>(base + (size_t)r0 * 1024);
  __syncthreads();
  float fp[8], fc[8], fn[8];
  unpack8(hprev, fp); unpack8(cur0, fc);
  for (int k = 0; k < PL; k += 8) {
    u32x4 rows[8];
#pragma unroll
    for (int j = 0; j < 8; ++j)
      rows[j] = (k + j + 1 < PL) ? *reinterpret_cast<const u32x4*>(base + (size_t)(r0 + k + j + 1) * 1024) : hnext;
#pragma unroll
    for (int j = 0; j < 8; ++j) {
      unpack8(rows[j], fn);
      float o[8];
#pragma unroll
      for (int i = 0; i < 8; ++i) o[i] = silu_f(w0[i] * fp[i] + w1[i] * fc[i] + w2[i] * fn[i] + bb[i]);
      *reinterpret_cast<u32x4*>(base + (size_t)(r0 + k + j) * 1024) = pack8(o);
#pragma unroll
      for (int i = 0; i < 8; ++i) { fp[i] = fc[i]; fc[i] = fn[i]; }
    }
  }
}

__device__ __forceinline__ void conv_hy_item(const Params& p, int l, int item, char* smem, int wvi) {
  const int tid = otid(wvi);
  const int pi = item / 3, part = item - pi * 3;
  int tok0; bool hasPrev = false, hasNext = false;
  if (pi < 1024) tok0 = pi * 64;
  else { const int j = pi - 1024, qq = j & 3; tok0 = TL + (j >> 2) * 256 + qq * 64; hasPrev = qq > 0; hasNext = qq < 3; }
  bf16_t* sIn = reinterpret_cast<bf16_t*>(smem);
  bf16_t* sOut = sIn + 66 * 264;
  const bf16_t* ph = p.big + part * 256;
  __syncthreads();
  for (int slot = tid; slot < 66 * 32; slot += 256) {
    const int r = slot >> 5, c8 = slot & 31;
    const bool valid = (r == 0) ? hasPrev : ((r == 65) ? hasNext : true);
    u32x4 v = zero_u4();
    if (valid) v = *reinterpret_cast<const u32x4*>(ph + (size_t)(tok0 - 1 + r) * 768 + c8 * 8);
    *reinterpret_cast<u32x4*>(sIn + r * 264 + c8 * 8) = v;
  }
  __syncthreads();
  {
    const int c = tid, ch = part * 256 + c;
    const float* cw = p.hy_conv_w + (size_t)l * 3 * 768 + ch;
    const float w0 = cw[0], w1 = cw[768], w2 = cw[1536], bb = p.hy_conv_b[l * 768 + ch];
    float a = bf2f(sIn[c]), b = bf2f(sIn[264 + c]);
#pragma unroll 8
    for (int t = 0; t < 64; ++t) {
      const float cn = bf2f(sIn[(t + 2) * 264 + c]);
      sOut[c * 66 + t] = f2bf(w0 * a + w1 * b + w2 * cn + bb);
      a = b; b = cn;
    }
  }
  __syncthreads();
#pragma unroll
  for (int i = 0; i < 4; ++i) {
    const int slot = tid + 256 * i, c = slot >> 2, q4 = slot & 3;
    const unsigned* sp = reinterpret_cast<const unsigned*>(sOut + c * 66 + q4 * 16);
    u32x4 v0 = mk4(sp[0], sp[1], sp[2], sp[3]), v1 = mk4(sp[4], sp[5], sp[6], sp[7]);
    bf16_t* dp = p.hyT + (size_t)(part * 256 + c) * TA + tok0 + q4 * 16;
    *reinterpret_cast<u32x4*>(dp) = v0;
    *reinterpret_cast<u32x4*>(dp + 8) = v1;
  }
}

__device__ __forceinline__ void shortconv_tokens(const Params& p, int l, int wvi) {
  const int tid = otid(wvi); const int lane = tid & 63, w = tid >> 6;
  const int nw = vgrid() * 4;
  const bf16_t* ps = p.big + (size_t)TA * 2304;
  const int ch = lane * 4;
  float w0[4], w1[4], w2[4], gn[4];
#pragma unroll
  for (int i = 0; i < 4; ++i) {
    w0[i] = p.sc_conv_w[l * 768 + ch + i]; w1[i] = p.sc_conv_w[l * 768 + 256 + ch + i]; w2[i] = p.sc_conv_w[l * 768 + 512 + ch + i];
    gn[i] = p.mix_gain[l * 1024 + 768 + ch + i];
  }
  const int per = (TA + nw - 1) / nw, gw = obid(wvi) * 4 + w;
  const int r0 = gw * per, r1 = min(TA, r0 + per);
  if (r0 >= r1) return;
  const u32x2 z2 = mk2(0u, 0u);
  u32x2 gcp = z2, hxp = z2, gcc, hxc, gbc, gcn = z2, hxn = z2, gbn = z2;
  if (r0 > 0) { gcp = *reinterpret_cast<const u32x2*>(ps + (size_t)(r0 - 1) * 768 + 256 + ch); hxp = *reinterpret_cast<const u32x2*>(ps + (size_t)(r0 - 1) * 768 + 512 + ch); }
  gbc = *reinterpret_cast<const u32x2*>(ps + (size_t)r0 * 768 + ch);
  gcc = *reinterpret_cast<const u32x2*>(ps + (size_t)r0 * 768 + 256 + ch);
  hxc = *reinterpret_cast<const u32x2*>(ps + (size_t)r0 * 768 + 512 + ch);
  for (int tok = r0; tok < r1; ++tok) {
    if (tok + 1 < TA) {
      const bf16_t* np = ps + (size_t)(tok + 1) * 768 + ch;
      gbn = *reinterpret_cast<const u32x2*>(np); gcn = *reinterpret_cast<const u32x2*>(np + 256); hxn = *reinterpret_cast<const u32x2*>(np + 512);
    }
    int ps_, sl;
    if (tok < TL) { ps_ = tok & 63; sl = 64; } else { ps_ = (tok - TL) & 255; sl = 256; }
    const float mp = (ps_ > 0) ? 1.f : 0.f, mn = (ps_ < sl - 1) ? 1.f : 0.f;
    float v[4];
    v[0] = lo2f(gbc.x) * (mp * w0[0] * lo2f(gcp.x) * lo2f(hxp.x) + w1[0] * lo2f(gcc.x) * lo2f(hxc.x) + mn * w2[0] * lo2f(gcn.x) * lo2f(hxn.x));
    v[1] = hi2f(gbc.x) * (mp * w0[1] * hi2f(gcp.x) * hi2f(hxp.x) + w1[1] * hi2f(gcc.x) * hi2f(hxc.x) + mn * w2[1] * hi2f(gcn.x) * hi2f(hxn.x));
    v[2] = lo2f(gbc.y) * (mp * w0[2] * lo2f(gcp.y) * lo2f(hxp.y) + w1[2] * lo2f(gcc.y) * lo2f(hxc.y) + mn * w2[2] * lo2f(gcn.y) * lo2f(hxn.y));
    v[3] = hi2f(gbc.y) * (mp * w0[3] * hi2f(gcp.y) * hi2f(hxp.y) + w1[3] * hi2f(gcc.y) * hi2f(hxc.y) + mn * w2[3] * hi2f(gcn.y) * hi2f(hxn.y));
    float ss = wave_sum(v[0] * v[0] + v[1] * v[1] + v[2] * v[2] + v[3] * v[3]);
    const float rstd = rsqrtf(ss * (1.f / 256.f) + EPS);
    *reinterpret_cast<u32x2*>(p.bufA + (size_t)tok * DM + 768 + ch) =
        mk2(pk2(v[0] * rstd * gn[0], v[1] * rstd * gn[1]), pk2(v[2] * rstd * gn[2], v[3] * rstd * gn[3]));
    gcp = gcc; hxp = hxc; gcc = gcn; hxc = hxn; gbc = gbn;
  }
}

__device__ __forceinline__ void conv_phase(const Params& p, int l, char* smem, int wvi) {
  const int n_ssd = 1040 * 4, n_hy = 1088 * 3;
  for (int it = obid(wvi); it < n_ssd; it += vgrid()) conv_ssd_item(p, l, it, wvi);
  for (int it = obid(wvi); it < n_hy; it += vgrid()) conv_hy_item(p, l, it, smem, wvi);
  shortconv_tokens(p, l, wvi);
}

typedef short s16x4 __attribute__((ext_vector_type(4)));
__device__ __forceinline__ bf16x8 tr8(const bf16_t* T, int stride, int srow0, int col0, int lane) {
  const int quad = lane >> 4, q = (lane & 15) >> 2, pp = lane & 3;
  const bf16_t* a0 = T + (srow0 + 8 * quad + q) * stride + col0 + 4 * pp;
  const s16x4 lo = __builtin_amdgcn_ds_read_tr16_b64_v4i16((GLAS s16x4*)a0);
  const s16x4 hi = __builtin_amdgcn_ds_read_tr16_b64_v4i16((GLAS s16x4*)(a0 + 4 * stride));
  return (bf16x8){lo[0], lo[1], lo[2], lo[3], hi[0], hi[1], hi[2], hi[3]};
}
__device__ __forceinline__ float bperm_f(int src_lane, float v) { return __int_as_float(__builtin_amdgcn_ds_bpermute(src_lane << 2, __float_as_int(v))); }

__device__ __forceinline__ void ssd_scan_item(const Params& p, int l, int item, char* smem, int wvi) {
  const int tid = otid(wvi), lane = tid & 63, w = tid >> 6, l16 = lane & 15, quad = lane >> 4;
  const int wg_ = item >> 1, xcd_ = wg_ & 7, k_ = wg_ >> 3, j_ = k_ & 7, G_ = (k_ >> 3) * 8 + xcd_;
  const int ph = item & 1, dir = j_ & 1, b = G_ >> 1, g = G_ & 1, h = g * 4 + (j_ >> 1);
  const bool last = (l == DEPTH - 1);
  bf16_t* sC = reinterpret_cast<bf16_t*>(smem);
  bf16_t* sB = sC + 64 * 136;
  bf16_t* sXd = sB + 64 * 136;
  bf16_t* sXw = sXd + 64 * 36;
  bf16_t* sM = sXw + 64 * 36;
  bf16_t* sH0 = sM + 64 * 72;
  float* sAcsW = reinterpret_cast<float*>(sH0 + 2 * 32 * 136) + w * 64;
  const bf16_t* pxbc = p.big + (size_t)TA * 1280;
  bf16_t* ydir = p.bufB + (size_t)dir * TA * 512;
  const float aco = -expf(p.a_log[l * 16 + dir * 8 + h]);

  __syncthreads();
  for (int i = tid; i < 2 * 32 * 136 / 8; i += 256) reinterpret_cast<u32x4*>(sH0)[i] = zero_u4();
  f32x4 hacc[2][2];
#pragma unroll
  for (int a = 0; a < 2; ++a)
#pragma unroll
    for (int c = 0; c < 2; ++c) hacc[a][c] = zero4();

  u32x4 rc[4], rb[4], rx; float rdt = 0.f;
  auto chunk_base = [&](int step) -> int {
    if (step < 4) { const int ck = dir ? 3 - step : step; return TL + b * 256 + ck * 64; }
    const int s2 = step - 4; const int ck = dir ? 63 - s2 : s2; return b * 4096 + ck * 64;
  };
  unsigned roff[4]; unsigned xoff, doff;
#pragma unroll
  for (int i = 0; i < 4; ++i) {
    const int slot = tid + 256 * i, row = slot >> 4, c8 = slot & 15;
    roff[i] = (unsigned)((dir ? 63 - row : row) * 1024 + g * 128 + c8 * 8);
  }
  { const int row = tid >> 2, c8 = tid & 3; xoff = (unsigned)((dir ? 63 - row : row) * 1024 + h * 64 + ph * 32 + c8 * 8); }
  doff = (unsigned)((dir ? 63 - lane : lane) * 16 + dir * 8 + h);
  auto issue = [&](int step) {
    const int base = chunk_base(step);
    const bf16_t* cb = pxbc + (size_t)base * 1024;
    const float* db = p.dtb + (size_t)base * 16;
#pragma unroll
    for (int i = 0; i < 4; ++i) {
      rb[i] = *reinterpret_cast<const u32x4*>(cb + 512 + roff[i]);
      rc[i] = *reinterpret_cast<const u32x4*>(cb + 768 + roff[i]);
    }
    rx = *reinterpret_cast<const u32x4*>(cb + xoff);
    rdt = db[doff];
  };
  issue(0);
  const int lidx = 16 * w + l16;
  const unsigned yoff = (unsigned)((dir ? 63 - lidx : lidx) * 512 + h * 64 + ph * 32 + quad * 4);
  float acs = rdt * aco;
#pragma unroll
  for (int o = 1; o < 64; o <<= 1) { const float t = bperm_f(lane - o, acs); acs += (lane >= o) ? t : 0.f; }
  for (int step = 0; step < 68; ++step) {
    const int base = chunk_base(step);
    const bf16_t* sH = sH0 + (step & 1) * (32 * 136);
    bf16_t* sHn = sH0 + ((step + 1) & 1) * (32 * 136);
    __syncthreads();
#pragma unroll
    for (int i = 0; i < 4; ++i) {
      const int slot = tid + 256 * i, row = slot >> 4, c8 = slot & 15;
      *reinterpret_cast<u32x4*>(sC + row * 136 + c8 * 8) = rc[i];
      *reinterpret_cast<u32x4*>(sB + row * 136 + c8 * 8) = rb[i];
    }
    const float dt_cur = rdt;
    const float Atot = __int_as_float(__builtin_amdgcn_readlane(__float_as_int(acs), 63));
    sAcsW[lane] = acs;
    {
      const int row = tid >> 2, c8 = tid & 3;
      const float acs_r = bperm_f(row, acs), dtv = bperm_f(row, dt_cur);
      const float wv = __expf(Atot - acs_r);
      float f[8]; unpack8(rx, f);
      u32x2* d0 = reinterpret_cast<u32x2*>(sXd + row * 36 + c8 * 8);
      u32x2* d1 = reinterpret_cast<u32x2*>(sXw + row * 36 + c8 * 8);
      float a[8];
#pragma unroll
      for (int i = 0; i < 8; ++i) a[i] = f[i] * dtv;
      d0[0] = mk2(pk2(a[0], a[1]), pk2(a[2], a[3])); d0[1] = mk2(pk2(a[4], a[5]), pk2(a[6], a[7]));
      d1[0] = mk2(pk2(a[0] * wv, a[1] * wv), pk2(a[2] * wv, a[3] * wv)); d1[1] = mk2(pk2(a[4] * wv, a[5] * wv), pk2(a[6] * wv, a[7] * wv));
    }
    if (step + 1 < 68) issue(step + 1);
    __syncthreads();
    bf16x8 cfr[4];
#pragma unroll
    for (int kk = 0; kk < 4; ++kk) cfr[kk] = ldfrag(sC + lidx * 136 + kk * 32 + quad * 8);
    const float al = sAcsW[lidx];
    {
#pragma unroll
      for (int st = 0; st < 4; ++st) {
        float m[4];
        {
          f32x4 acc = zero4();
#pragma unroll
          for (int kk = 0; kk < 4; ++kk) acc = mfma16(ldfrag(sB + (16 * st + l16) * 136 + kk * 32 + quad * 8), cfr[kk], acc);
          const float4 as4 = *reinterpret_cast<const float4*>(sAcsW + 16 * st + quad * 4);
          const float asj[4] = {as4.x, as4.y, as4.z, as4.w};
#pragma unroll
          for (int j = 0; j < 4; ++j) {
            const int s = 16 * st + quad * 4 + j;
            const float msk = (s <= lidx) ? 1.f : 0.f;
            m[j] = acc[j] * __expf(fminf(al - asj[j], 0.f)) * msk;
          }
        }
        *reinterpret_cast<u32x2*>(sM + lidx * 72 + 16 * st + quad * 4) = mk2(pk2(m[0], m[1]), pk2(m[2], m[3]));
      }
    }
    {
      const float el = __expf(al);
      bf16_t* yb_ = ydir + (size_t)base * 512;
      bf16x8 mfr[2];
      mfr[0] = ldfrag(sM + lidx * 72 + quad * 8);
      mfr[1] = ldfrag(sM + lidx * 72 + 32 + quad * 8);
#pragma unroll
      for (int pt = 0; pt < 2; ++pt) {
        f32x4 acc = zero4();
#pragma unroll
        for (int kk = 0; kk < 4; ++kk) acc = mfma16(ldfrag(sH + (16 * pt + l16) * 136 + kk * 32 + quad * 8), cfr[kk], acc);
        acc[0] *= el; acc[1] *= el; acc[2] *= el; acc[3] *= el;
        acc = mfma16(tr8(sXd, 36, 0, 16 * pt, lane), mfr[0], acc);
        acc = mfma16(tr8(sXd, 36, 32, 16 * pt, lane), mfr[1], acc);
        *reinterpret_cast<u32x2*>(yb_ + yoff + 16 * pt) =
              mk2(pk2(acc[0], acc[1]), pk2(acc[2], acc[3]));
      }
    }
    {
      const float eT = __expf(Atot);
#pragma unroll
      for (int a = 0; a < 2; ++a)
#pragma unroll
        for (int c = 0; c < 2; ++c) { hacc[a][c][0] *= eT; hacc[a][c][1] *= eT; hacc[a][c][2] *= eT; hacc[a][c][3] *= eT; }
#pragma unroll
      for (int kk = 0; kk < 2; ++kk) {
        bf16x8 af[2], bq[2];
#pragma unroll
        for (int nti = 0; nti < 2; ++nti) af[nti] = tr8(sB, 136, 32 * kk, 16 * (2 * w + nti), lane);
#pragma unroll
        for (int pt = 0; pt < 2; ++pt) bq[pt] = tr8(sXw, 36, 32 * kk, 16 * pt, lane);
#pragma unroll
        for (int nti = 0; nti < 2; ++nti)
#pragma unroll
          for (int pt = 0; pt < 2; ++pt) hacc[nti][pt] = mfma16(af[nti], bq[pt], hacc[nti][pt]);
      }
#pragma unroll
      for (int nti = 0; nti < 2; ++nti)
#pragma unroll
        for (int pt = 0; pt < 2; ++pt) {
          const f32x4 v = hacc[nti][pt];
          *reinterpret_cast<u32x2*>(sHn + (16 * pt + l16) * 136 + 16 * (2 * w + nti) + quad * 4) = mk2(pk2(v[0], v[1]), pk2(v[2], v[3]));
        }
      float nacs = rdt * aco;
#pragma unroll
      for (int o = 1; o < 64; o <<= 1) { const float t = bperm_f(lane - o, nacs); nacs += (lane >= o) ? t : 0.f; }
      acs = nacs;
    }
  }
}

__device__ __forceinline__ void ssd_combine_tokens(const Params& p, int l, int rows, int wvi) {
  const int tid = otid(wvi); const int lane = tid & 63, w = tid >> 6;
  const int nw = vgrid() * 4;
  const int ch = lane * 8;
  const float Dv = p.ssd_d[l * 8 + (lane >> 3)];
  float gn[8];
#pragma unroll
  for (int i = 0; i < 8; ++i) gn[i] = p.mix_gain[l * 1024 + 256 + ch + i];
  const bf16_t* pz = p.big + (size_t)TA * 768;
  const bf16_t* pxbc = p.big + (size_t)TA * 1280;
  const int per = (rows + nw - 1) / nw, gw = obid(wvi) * 4 + w;
  const int r0 = gw * per, r1 = min(rows, r0 + per);
  if (r0 >= r1) return;
  u32x4 nyf, nyb, nxs, nzz;
  auto fetch = [&](int tok) {
    nyf = *reinterpret_cast<const u32x4*>(p.bufB + (size_t)tok * 512 + ch);
    nyb = *reinterpret_cast<const u32x4*>(p.bufB + (size_t)TA * 512 + (size_t)tok * 512 + ch);
    nxs = *reinterpret_cast<const u32x4*>(pxbc + (size_t)tok * 1024 + ch);
    nzz = *reinterpret_cast<const u32x4*>(pz + (size_t)tok * 512 + ch);
  };
  fetch(r0);
  for (int tok = r0; tok < r1; ++tok) {
    float yf[8], yb[8], xs[8], zz[8], v[8];
    unpack8(nyf, yf); unpack8(nyb, yb); unpack8(nxs, xs); unpack8(nzz, zz);
    if (tok + 1 < r1) fetch(tok + 1);
    float ss = 0.f;
#pragma unroll
    for (int i = 0; i < 8; ++i) { v[i] = (yf[i] + yb[i] + Dv * xs[i]) * silu_f(zz[i]); ss += v[i] * v[i]; }
    ss = wave_sum(ss);
    const float rstd = rsqrtf(ss * (1.f / 512.f) + EPS);
#pragma unroll
    for (int i = 0; i < 8; ++i) v[i] *= rstd * gn[i];
    *reinterpret_cast<u32x4*>(p.bufA + (size_t)tok * DM + 256 + ch) = pack8(v);
  }
}

__device__ __forceinline__ void hy_lat_item(const Params& p, int l, int o, int item, char* smem, int wvi) {
  const int tid = otid(wvi), lane = tid & 63, w = tid >> 6, l16 = lane & 15, quad = lane >> 4;
  const int c = item >> 2, bg = item & 3;
  bf16_t* sE = reinterpret_cast<bf16_t*>(smem);
  bf16_t* sO = sE + 8192 + 32;
  bf16_t* sZ = sO + 8192 + 32;
  const float* kf = p.kfl + (size_t)(o * 256 + c) * 8192;
  bf16_t* zrow = p.hyT + (size_t)c * TA;
  const bf16_t* grow = p.hyT + (size_t)((o + 1) * 256 + c) * TA;
  __syncthreads();
  for (int q = tid; q < 8192; q += 256) {
    const bf16_t r = (q == 0) ? (bf16_t)0 : f2bf(kf[8192 - q]);
    sE[q] = r;
    if (q >= 1) sO[q - 1] = r;
  }
  if (tid == 0) sO[8191] = 0;
  if (tid < 36) reinterpret_cast<unsigned*>(sZ + 4 * 4608)[tid] = 0u;
#pragma unroll
  for (int i = 0; i < 8; ++i) {
    const int slot = tid + 256 * i, bl = slot >> 9, s = (slot & 511) * 8;
    const u32x4 v = *reinterpret_cast<const u32x4*>(zrow + (size_t)(bg * 4 + bl) * SEQ + s);
    *reinterpret_cast<u32x4*>(sZ + bl * 4608 + (s >> 6) * 72 + (s & 63)) = v;
  }
  __syncthreads();
  f32x4 acc[4][4];
#pragma unroll
  for (int a = 0; a < 4; ++a)
#pragma unroll
    for (int b2 = 0; b2 < 4; ++b2) acc[a][b2] = zero4();
  const bf16_t* zw = sZ + w * 4608;
  auto ldG = [&](const bf16_t* cp, int q0) -> bf16x8 {
    const unsigned* pp = reinterpret_cast<const unsigned*>(cp + q0);
    u32x4 t = {pp[0], pp[1], pp[2], pp[3]};
    return __builtin_bit_cast(bf16x8, t);
  };
  const bf16_t* cE = sE;
  const bf16_t* cO = sO - 2;
  const int qb = 4096 - 2 * l16 + 8 * quad;
  bf16x8 e_p32 = ldG(cE, qb + 64 * 63 + 32), e_0 = ldG(cE, qb + 64 * 63), e_m32 = ldG(cE, qb + 64 * 63 - 32);
  bf16x8 o_p32 = ldG(cO, qb + 64 * 63 + 32), o_0 = ldG(cO, qb + 64 * 63), o_m32 = ldG(cO, qb + 64 * 63 - 32);
  const bf16_t* zrow0 = sZ + 4 * 4608;
  bf16x8 bcur[4][2], bnxt[4][2];
  auto ldB = [&](int d1v, bf16x8 (&bd)[4][2]) {
#pragma unroll
    for (int nt = 0; nt < 4; ++nt) {
      const int s1 = 16 * nt + l16 - d1v;
      const bf16_t* bp = ((unsigned)s1 < 64u) ? (zw + s1 * 72) : zrow0;
      bd[nt][0] = ldfrag(bp + 8 * quad);
      bd[nt][1] = ldfrag(bp + 32 + 8 * quad);
    }
  };
  ldB(-63, bcur);
#define HY_SEG(D0, D1, NT0, NT1) \
  _Pragma("unroll 1") for (int d1 = (D0); d1 <= (D1); ++d1) { \
    const int dn = (d1 < 63) ? d1 + 1 : 63; \
    const int qn = qb - 64 * dn; \
    const bf16x8 ne0 = ldG(cE, qn), nem = ldG(cE, qn - 32), no0 = ldG(cO, qn), nom = ldG(cO, qn - 32); \
    ldB(dn, bnxt); \
    _Pragma("unroll") for (int nt = (NT0); nt <= (NT1); ++nt) { \
      acc[0][nt] = mfma16(e_0, bcur[nt][0], acc[0][nt]);   acc[1][nt] = mfma16(o_0, bcur[nt][0], acc[1][nt]); \
      acc[2][nt] = mfma16(e_m32, bcur[nt][0], acc[2][nt]); acc[3][nt] = mfma16(o_m32, bcur[nt][0], acc[3][nt]); \
      acc[0][nt] = mfma16(e_p32, bcur[nt][1], acc[0][nt]); acc[1][nt] = mfma16(o_p32, bcur[nt][1], acc[1][nt]); \
      acc[2][nt] = mfma16(e_0, bcur[nt][1], acc[2][nt]);   acc[3][nt] = mfma16(o_0, bcur[nt][1], acc[3][nt]); \
    } \
    e_p32 = e_m32; o_p32 = o_m32; e_0 = ne0; e_m32 = nem; o_0 = no0; o_m32 = nom; \
    _Pragma("unroll") for (int nt = 0; nt < 4; ++nt) { bcur[nt][0] = bnxt[nt][0]; bcur[nt][1] = bnxt[nt][1]; } \
  }
  HY_SEG(-63, -48, 0, 0)
  HY_SEG(-47, -32, 0, 1)
  HY_SEG(-31, -16, 0, 2)
  HY_SEG(-15, 15, 0, 3)
  HY_SEG(16, 31, 1, 3)
  HY_SEG(32, 47, 2, 3)
  HY_SEG(48, 63, 3, 3)
#undef HY_SEG
  const float bias = p.hy_bias[l * 512 + o * 256 + c];
  const int bglob = bg * 4 + w;
#pragma unroll
  for (int h = 0; h < 2; ++h)
#pragma unroll
    for (int nt = 0; nt < 4; ++nt) {
      const int t1 = 16 * nt + l16;
      const f32x4 ye = acc[2 * h][nt], yo = acc[2 * h + 1][nt];
#pragma unroll
      for (int j = 0; j < 4; ++j) {
        const int t2 = 32 * h + 2 * (4 * quad + j);
        const unsigned zo = *reinterpret_cast<const unsigned*>(zw + t1 * 72 + t2);
        const size_t gi = (size_t)bglob * SEQ + t1 * 64 + t2;
        const unsigned gt = *reinterpret_cast<const unsigned*>(grow + gi);
        const float r0 = lo2f(gt) * (ye[j] + bias * lo2f(zo)), r1 = hi2f(gt) * (yo[j] + bias * hi2f(zo));
        *reinterpret_cast<unsigned*>(zrow + gi) = pk2(r0, r1);
      }
    }
}

__device__ __forceinline__ void hy_ctx_item(const Params& p, int l, int o, int item, char* smem, int wvi) {
  const int tid = otid(wvi);
  const int c = item >> 1, bh = item & 1;
  float* sK = reinterpret_cast<float*>(smem);
  float* sZc = sK + 512;
  const float* kf = p.kfc + (size_t)(o * 256 + c) * 512;
  bf16_t* zrow = p.hyT + (size_t)c * TA + TL + bh * 2048;
  const bf16_t* grow = p.hyT + (size_t)((o + 1) * 256 + c) * TA + TL + bh * 2048;
  __syncthreads();
  for (int i = tid; i < 512; i += 256) sK[i] = (i >= 1) ? kf[i] : 0.f;
  for (int i = tid; i < 2048; i += 256) sZc[(i >> 8) * 257 + (i & 255)] = bf2f(zrow[i]);
  __syncthreads();
  const int b = tid >> 5, tq = tid & 31;
  float acc[8];
#pragma unroll
  for (int i = 0; i < 8; ++i) acc[i] = 0.f;
  float tw[8];
#pragma unroll
  for (int i = 0; i < 8; ++i) tw[i] = sK[256 + tq * 8 + i];
#pragma unroll 8
  for (int s = 0; s < 256; ++s) {
    const float zv = sZc[b * 257 + s];
#pragma unroll
    for (int i = 0; i < 8; ++i) acc[i] += tw[i] * zv;
#pragma unroll
    for (int i = 7; i > 0; --i) tw[i] = tw[i - 1];
    tw[0] = sK[(256 + tq * 8 - s - 1) & 511];
  }
  const float bias = p.hy_bias[l * 512 + o * 256 + c];
  float res[8];
#pragma unroll
  for (int i = 0; i < 8; ++i) {
    const int t = tq * 8 + i;
    res[i] = bf2f(grow[b * 256 + t]) * (acc[i] + bias * sZc[b * 257 + t]);
  }
  __syncthreads();
  *reinterpret_cast<u32x4*>(zrow + b * 256 + tq * 8) = pack8(res);
}

__device__ __forceinline__ void hy_final_item(const Params& p, int l, int pi, char* smem, int wvi) {
  const int tid = otid(wvi), lane = tid & 63, w = tid >> 6;
  const int tok0 = pi * 64;
  bf16_t* sZ = reinterpret_cast<bf16_t*>(smem);
  float* sRed = reinterpret_cast<float*>(sZ + 256 * 66);
  float* sRs = sRed + 256;
  __syncthreads();
#pragma unroll
  for (int i = 0; i < 8; ++i) {
    const int slot = tid + 256 * i, c = slot >> 3, part = slot & 7;
    const u32x4 v = *reinterpret_cast<const u32x4*>(p.hyT + (size_t)c * TA + tok0 + part * 8);
    unsigned* d = reinterpret_cast<unsigned*>(sZ + c * 66 + part * 8);
    d[0] = v.x; d[1] = v.y; d[2] = v.z; d[3] = v.w;
  }
  __syncthreads();
  {
    const int t = tid & 63, qd = tid >> 6;
    float ss = 0.f;
    for (int c = qd * 64; c < qd * 64 + 64; ++c) { const float v = bf2f(sZ[c * 66 + t]); ss += v * v; }
    sRed[qd * 64 + t] = ss;
  }
  __syncthreads();
  if (tid < 64) sRs[tid] = rsqrtf((sRed[tid] + sRed[64 + tid] + sRed[128 + tid] + sRed[192 + tid]) * (1.f / 256.f) + EPS);
  __syncthreads();
  const int ch = lane * 4;
  float gn[4];
#pragma unroll
  for (int i = 0; i < 4; ++i) gn[i] = p.mix_gain[l * 1024 + ch + i];
  for (int tt = 0; tt < 16; ++tt) {
    const int t = w * 16 + tt; const float rs = sRs[t];
    const float v0 = bf2f(sZ[(ch + 0) * 66 + t]) * rs * gn[0], v1 = bf2f(sZ[(ch + 1) * 66 + t]) * rs * gn[1];
    const float v2 = bf2f(sZ[(ch + 2) * 66 + t]) * rs * gn[2], v3 = bf2f(sZ[(ch + 3) * 66 + t]) * rs * gn[3];
    *reinterpret_cast<u32x2*>(p.bufA + (size_t)(tok0 + t) * DM + ch) = mk2(pk2(v0, v1), pk2(v2, v3));
  }
}

constexpr int NPHASES = 2 + 13 * DEPTH;

__device__ __forceinline__ void run_phase(const Params& p, int ph, char* smem0, int wvi) {
  char* smem = smem0 + (wvi >> 2) * HALF_LDS;
  if (ph == 0) { prep_sub(p, 0, smem, wvi, obid(wvi), vgrid(), PS_MOD | PS_FIN0); return; }
  NormCfg cf;
  if (ph == 1) {
    cf.src_lat = p.x; cf.src_ctx = p.ctx; cf.xs = p.xs; cf.out32 = nullptr; cf.y = nullptr; cf.g_post = nullptr; cf.mod_post = nullptr;
    cf.gate_i = 0; cf.res_w = 0.f; cf.g_pre = p.norm_g; cf.mod_pre = p.mod; cf.shift_i = 0; cf.h = p.bufA; cf.rows = TA;
    norm_phase(cf, wvi); return;
  }
  const int l = (ph - 2) / 13, s = (ph - 2) - l * 13;
  const bool last = (l == DEPTH - 1);
  const float* g = p.norm_g + (size_t)l * 6 * DM;
  const float* modl = p.mod + (size_t)l * MODLAYER;
  const float* xs_lat = (l == 0 && s <= 2) ? p.x : nullptr;
  const float* xs_ctx = (l == 0 && s <= 2) ? p.ctx : nullptr;
  switch (s) {
    case 0:
      gemm_phase(p, l, p.bufA, p.wFin0, TA, 2 * DFF, DM, EPI_SWIGLU, p.big, smem0, wvi);
      if (l == 0 && blockIdx.x >= 96) prep_sub(p, 0, smem, wvi, obid(wvi) - 192, vgrid() - 192, PS_FOUT0 | PS_WIN);
      break;
    case 1:
      gemm_phase(p, l, p.big, p.wFout0, TA, DM, DFF, EPI_PLAIN, p.bufB, smem0, wvi);
      if (blockIdx.x >= 64) {
        if (l == 0) prep_sub(p, 0, smem, wvi, obid(wvi) - 128, vgrid() - 128, PS_FILT | PS_FIN1 | PS_FOUT1 | PS_WOUT);
        else if (!last) prep_sub(p, l + 1, smem, wvi, obid(wvi) - 128, vgrid() - 128, PS_FIN0);
      }
      break;
    case 2:
      cf.src_lat = xs_lat; cf.src_ctx = xs_ctx; cf.xs = p.xs; cf.out32 = nullptr; cf.y = p.bufB; cf.g_post = g + DM; cf.mod_post = modl;
      cf.gate_i = 2; cf.res_w = 0.5f; cf.g_pre = g + 2 * DM; cf.mod_pre = modl; cf.shift_i = 3; cf.h = p.bufA; cf.rows = TA;
      norm_phase(cf, wvi); break;
    case 3: gemm_phase(p, l, p.bufA, p.wIn, TA, 3328, DM, EPI_INPROJ, nullptr, smem0, wvi); break;
    case 4: conv_phase(p, l, smem, wvi); break;
    case 5: {
      for (int it = obid(wvi); it < 512; it += vgrid()) ssd_scan_item(p, l, it, smem, wvi);
      const int nctx = last ? 0 : 512;
      for (int it = obid(wvi); it < 1024 + nctx; it += vgrid()) {
        if (it < nctx) hy_ctx_item(p, l, 0, it, smem, wvi); else hy_lat_item(p, l, 0, it - nctx, smem, wvi);
      }
    } break;
    case 6: {
      const int nctx = last ? 0 : 512;
      for (int it = obid(wvi); it < 1024 + nctx; it += vgrid()) {
        if (it < nctx) hy_ctx_item(p, l, 1, it, smem, wvi); else hy_lat_item(p, l, 1, it - nctx, smem, wvi);
      }
      ssd_combine_tokens(p, l, last ? TL : TA, wvi);
    } break;
    case 7: {
      const int np = last ? 1024 : 1088;
      for (int it = obid(wvi); it < np; it += vgrid()) hy_final_item(p, l, it, smem, wvi);
    } break;
    case 8: gemm_phase(p, l, p.bufA, p.wOut, last ? TL : TA, DM, DM, EPI_PLAIN, p.bufB, smem0, wvi); break;
    case 9:
      cf.src_lat = nullptr; cf.src_ctx = nullptr; cf.xs = p.xs; cf.out32 = nullptr; cf.y = p.bufB; cf.g_post = g + 3 * DM; cf.mod_post = modl;
      cf.gate_i = 5; cf.res_w = 1.0f; cf.g_pre = g + 4 * DM; cf.mod_pre = modl; cf.shift_i = 6; cf.h = p.bufA; cf.rows = last ? TL : TA;
      norm_phase(cf, wvi); break;
    case 10: gemm_phase(p, l, p.bufA, p.wFin1, last ? TL : TA, 2 * DFF, DM, EPI_SWIGLU, p.big, smem0, wvi); break;
    case 11:
      gemm_phase(p, l, p.big, p.wFout1, last ? TL : TA, DM, DFF, EPI_PLAIN, p.bufB, smem0, wvi);
      if (!last && blockIdx.x >= 64) prep_sub(p, l + 1, smem, wvi, obid(wvi) - 128, vgrid() - 128, PS_FILT | PS_FIN1 | PS_FOUT0 | PS_WIN | PS_WOUT | (l == 0 ? PS_FIN0 : 0));
      break;
    case 12:
      cf.src_lat = nullptr; cf.src_ctx = nullptr; cf.xs = p.xs; cf.out32 = last ? p.out : nullptr; cf.y = p.bufB; cf.g_post = g + 5 * DM; cf.mod_post = modl;
      cf.gate_i = 8; cf.res_w = 0.5f; cf.rows = last ? TL : TA;
      if (!last) { cf.g_pre = g + 6 * DM; cf.mod_pre = modl + MODLAYER; cf.shift_i = 0; cf.h = p.bufA; }
      else { cf.g_pre = nullptr; cf.mod_pre = nullptr; cf.shift_i = 0; cf.h = nullptr; }
      norm_phase(cf, wvi);
      if (!last) prep_sub(p, l + 1, smem, wvi, obid(wvi), vgrid(), PS_FOUT1);
      break;
  }
}


#define XB_TMO      128
#define XB_XCNT(j)  (256  + 64 * (j))
#define XB_XSUB(j)  (1280 + 64 * (j))
#define XB_XGEN(j)  (2304 + 64 * (j))
#define XB_TOP      3328
#define XB_TOPGEN   3392
#define XCD_BAR_WORDS 3456
#define XB_SPIN_CAP (1u << 18)
__device__ __forceinline__ unsigned xb_ld(unsigned* p)              { return __hip_atomic_load(p, __ATOMIC_RELAXED, __HIP_MEMORY_SCOPE_AGENT); }
__device__ __forceinline__ unsigned xb_add(unsigned* p, unsigned v) { return __hip_atomic_fetch_add(p, v, __ATOMIC_RELAXED, __HIP_MEMORY_SCOPE_AGENT); }
__device__ __forceinline__ unsigned xb_xcc_id() { return (unsigned)__builtin_amdgcn_s_getreg((3 << 11) | 20) & 0xFu; }
#define XB_SPIN(cond, bar) do { unsigned _sp = 0; while (cond) { __builtin_amdgcn_s_sleep(1); \
    if ((++_sp & 255u) == 0u) { if (xb_ld(&(bar)[XB_TMO])) break; if (_sp > XB_SPIN_CAP) { atomicAdd(&(bar)[XB_TMO], 1u); break; } } } } while (0)
struct XcdBarrier { unsigned* bar; unsigned x; volatile GLAS unsigned* st; };
__device__ __forceinline__ void xcd_barrier_complete(unsigned* bar, unsigned x, unsigned& nloc, unsigned& nx) {
  const unsigned G = gridDim.x * gridDim.y * gridDim.z;
  unsigned sum, cnt, mine, sp = 0u;
  for (;;) {
    sum = 0u; cnt = 0u; mine = 0u;
#pragma unroll
    for (unsigned j = 0; j < 16; ++j) { const unsigned c = xb_ld(&bar[XB_XCNT(j)]); sum += c; cnt += (c > 0u) ? 1u : 0u; mine = (j == x) ? c : mine; }
    if (sum == G) break;
    __builtin_amdgcn_s_sleep(1);
    if ((++sp & 255u) == 0u) { if (xb_ld(&bar[XB_TMO])) break; if (sp > XB_SPIN_CAP) { atomicAdd(&bar[XB_TMO], 1u); break; } }
  }
  nloc = mine > 0u ? mine : 1u; nx = cnt > 0u ? cnt : 1u;
}
__device__ __forceinline__ void xcd_barrier(unsigned* bar_, volatile GLAS unsigned* st_, int wvi) {
  asm volatile("s_waitcnt vmcnt(0)" ::: "memory");
  __syncthreads();
  if (wvi == 0 && lane_id() == 0) {
    XcdBarrier b; b.bar = bar_; b.x = xb_xcc_id(); b.st = st_;
    unsigned* bar = b.bar;
    __builtin_amdgcn_s_waitcnt(0);
    unsigned nloc = b.st[0], nx = b.st[1];
    if (nloc == 0u) { xcd_barrier_complete(bar, b.x, nloc, nx); b.st[0] = nloc; b.st[1] = nx; }
    const unsigned old = xb_add(&bar[XB_XSUB(b.x)], 1u);
    const unsigned gen = old / nloc;
    if (old + 1u == (gen + 1u) * nloc) {
      __builtin_amdgcn_fence(__ATOMIC_RELEASE, "agent");
      asm volatile("s_waitcnt vmcnt(0)" ::: "memory");
      const unsigned og = xb_add(&bar[XB_TOP], 1u);
      const unsigned tg = og / nx;
      if (og + 1u == (tg + 1u) * nx) xb_add(&bar[XB_TOPGEN], 1u);
      else XB_SPIN(xb_ld(&bar[XB_TOPGEN]) == tg, bar);
      __builtin_amdgcn_fence(__ATOMIC_ACQUIRE, "agent");
      xb_add(&bar[XB_XGEN(b.x)], 1u);
      asm volatile("s_waitcnt vmcnt(0)" ::: "memory");
    } else {
      XB_SPIN(xb_ld(&bar[XB_XGEN(b.x)]) == gen, bar);
      __builtin_amdgcn_fence(__ATOMIC_ACQUIRE, "agent");
      asm volatile("s_waitcnt vmcnt(0)" ::: "memory");
    }
  }
  __syncthreads();
}

__global__ void __launch_bounds__(512) mega(Params p) {
  extern __shared__ __attribute__((aligned(16))) char smem[];
  cg::grid_group grid = cg::this_grid();
  const int wvi = __builtin_amdgcn_readfirstlane((int)(threadIdx.x >> 6));
  volatile GLAS unsigned* st = (volatile GLAS unsigned*)(smem + LDS_BYTES);
  if (threadIdx.x == 0) { st[0] = 0u; st[1] = 0u; st[2] = 0u; st[3] = 0u; (void)xb_add(&p.bar[XB_XCNT(xb_xcc_id())], 1u); }
  __syncthreads();
  for (int ph = p.ph_lo; ph < p.ph_hi; ++ph) {
    run_phase(p, ph, smem, wvi);
    if (ph + 1 < p.ph_hi) {
      if (ph == p.ph_lo) grid.sync();
      else xcd_barrier(p.bar, (volatile GLAS unsigned*)(smem + LDS_BYTES), wvi);
    }
  }
}

extern "C" void kernel_launch(void* const* d_in, const int* in_sizes, int n_in, void* d_out, int out_size, void* d_ws, size_t ws_size,
                              hipStream_t stream) {
  static int grid_blocks = 0;
  if (!grid_blocks) {
    int dev = 0, cus = 0, per_cu = 0;
    hipGetDevice(&dev);
    hipDeviceGetAttribute(&cus, hipDeviceAttributeMultiprocessorCount, dev);
    hipFuncSetAttribute((const void*)mega, hipFuncAttributeMaxDynamicSharedMemorySize, LDS_TOTAL);
    hipOccupancyMaxActiveBlocksPerMultiprocessor(&per_cu, (const void*)mega, 512, LDS_TOTAL);
    if (per_cu < 1) per_cu = 1;
    if (per_cu > 1) per_cu = 1;
    grid_blocks = cus * per_cu;
    fprintf(stderr, "kernel_launch: cus %d per_cu %d grid %d ws %zu\n", cus, per_cu, grid_blocks, ws_size);
  }
  Params p;
  memset(&p, 0, sizeof(p));
  const float* const* in = reinterpret_cast<const float* const*>(d_in);
  p.x = in[0]; p.c = in[1]; p.ctx = in[2]; p.c_ctx = in[3]; p.w_mod = in[4]; p.b_mod = in[5]; p.norm_g = in[6];
  p.ffn_w_in = in[7]; p.ffn_w_out = in[8]; p.w_in = in[9]; p.w_out = in[10]; p.hy_conv_w = in[11]; p.hy_conv_b = in[12];
  p.fw1 = in[13]; p.fb1 = in[14]; p.fw2 = in[15]; p.fb2 = in[16]; p.fw3 = in[17]; p.fb3 = in[18]; p.fw4 = in[19];
  p.freq = in[20]; p.hy_bias = in[21]; p.ssd_conv_w = in[22]; p.ssd_conv_b = in[23]; p.a_log = in[24]; p.dt_bias = in[25];
  p.ssd_d = in[26]; p.sc_conv_w = in[27]; p.mix_gain = in[28];
  p.out = reinterpret_cast<float*>(d_out);
  char* ws = reinterpret_cast<char*>(d_ws);
  size_t off = 0;
  auto take = [&](size_t bytes) -> char* { char* r = ws + off; off += (bytes + 255) & ~(size_t)255; return r; };
  p.wFin0 = (bf16_t*)take((size_t)2 * DFF * DM * 2);
  p.wFin1 = (bf16_t*)take((size_t)2 * DFF * DM * 2);
  p.wFout0 = (bf16_t*)take((size_t)DM * DFF * 2);
  p.wFout1 = (bf16_t*)take((size_t)DM * DFF * 2);
  p.wIn = (bf16_t*)take((size_t)3328 * DM * 2);
  p.wOut = (bf16_t*)take((size_t)DM * DM * 2);
  p.bufA = (bf16_t*)take((size_t)TA * DM * 2);
  p.bufB = (bf16_t*)take((size_t)TA * DM * 2);
  p.big = (bf16_t*)take((size_t)TA * 3072 * 2);
  p.hyT = (bf16_t*)take((size_t)3 * 256 * TA * 2);
  p.xs = (bf16_t*)take((size_t)TA * DM * 2);
  p.mod = (float*)take((size_t)DEPTH * MODLAYER * 4);
  p.kfl = (float*)take((size_t)2 * 256 * 8192 * 4);
  p.kfc = (float*)take((size_t)2 * 256 * 512 * 4);
  p.dtb = (float*)take((size_t)TA * 16 * 4);
  p.bar = (unsigned*)take((size_t)XCD_BAR_WORDS * 4);
  if (off > ws_size) { fprintf(stderr, "kernel_launch: workspace too small: need %zu have %zu\n", off, ws_size); return; }
  hipMemsetAsync(p.bar, 0, (size_t)XCD_BAR_WORDS * 4, stream);
#ifndef MK_MULTI
  p.ph_lo = 0; p.ph_hi = NPHASES;
  void* args[] = {&p};
  hipError_t e = hipLaunchCooperativeKernel((const void*)mega, dim3(grid_blocks), dim3(512), args, LDS_TOTAL, stream);
  if (e != hipSuccess) fprintf(stderr, "cooperative launch failed: %s (grid %d)\n", hipGetErrorString(e), grid_blocks);
#else
  for (int ph = 0; ph < NPHASES; ++ph) {
    p.ph_lo = ph; p.ph_hi = ph + 1;
    hipLaunchKernelGGL(mega, dim3(grid_blocks), dim3(512), LDS_TOTAL, stream, p);
  }
#endif
}
```
